# Optimizing an MI355X kernel written in HIP

```python
import math
import jax, jax.numpy as jnp
from jax import lax
import numpy as np

D_MODEL = 1024
BATCH = 8
SEQ = 4096
DEPTH = 1

C_CONV = D_MODEL
K_CONV = 31
HEAD_DIM = 64
N_HEADS = D_MODEL // HEAD_DIM
N_KV_HEADS = N_HEADS // 8
GROUP = N_HEADS // N_KV_HEADS
WINDOW = 128
Q_BLOCK = 128
N_EXPERTS = 32
TOP_K = 4
D_FF = D_MODEL
SWIGLU_LIMIT = 7.0
SWIGLU_ALPHA = 1.702
MOE_BLOCK = 128
EPS = 1e-5

N_GLU = 2 * C_CONV
N_Q = N_HEADS * HEAD_DIM
N_KV = N_KV_HEADS * HEAD_DIM
N_GATE = 2 * D_MODEL
N_IN = N_GLU + N_Q + 2 * N_KV + N_GATE

kernel_name = "hybrid_conformer_swa_sink_alibi_moe"


def rms_norm(x, g):
    xf = x.astype(jnp.float32)
    y = xf * lax.rsqrt(jnp.mean(xf * xf, axis=-1, keepdims=True) + EPS)
    return (y * g.astype(jnp.float32)).astype(x.dtype)


def layer_norm(x, g, b):
    xf = x.astype(jnp.float32)
    mu = jnp.mean(xf, axis=-1, keepdims=True)
    var = jnp.mean(jnp.square(xf - mu), axis=-1, keepdims=True)
    y = (xf - mu) * lax.rsqrt(var + EPS)
    return (y * g.astype(jnp.float32) + b.astype(jnp.float32)).astype(x.dtype)


def alibi_slopes(n_heads):
    return jnp.asarray([2.0 ** (-8.0 * (i + 1) / n_heads) for i in range(n_heads)], dtype=jnp.float32)


def conformer_conv(a, b, conv_w, conv_b, ln_g, ln_b, w_o, b_o):
    u = a * jax.nn.sigmoid(b)
    u = lax.conv_general_dilated(
        u, conv_w[:, None, :].astype(u.dtype), window_strides=(1,),
        padding=[(K_CONV - 1, 0)], dimension_numbers=("NWC", "WIO", "NWC"),
        feature_group_count=C_CONV) + conv_b
    u = jax.nn.silu(layer_norm(u, ln_g, ln_b))
    return u @ w_o + b_o


def sliding_window_attention(q, k, v, sinks):
    B, T = q.shape[0], q.shape[1]
    nb = T // Q_BLOCK
    qb = q.reshape(B, nb, Q_BLOCK, N_KV_HEADS, GROUP, HEAD_DIM)

    def band(t):
        cur = t.reshape(B, nb, Q_BLOCK, N_KV_HEADS, HEAD_DIM)
        prev = jnp.pad(t, ((0, 0), (Q_BLOCK, 0), (0, 0), (0, 0)))[:, :T]
        prev = prev.reshape(B, nb, Q_BLOCK, N_KV_HEADS, HEAD_DIM)
        return jnp.concatenate([prev, cur], axis=2)

    kb, vb = band(k), band(v)
    scale = 1.0 / math.sqrt(HEAD_DIM)
    s = jnp.einsum("bnqkgd,bnskd->bnkgqs", qb, kb).astype(jnp.float32) * scale

    qi = jnp.arange(Q_BLOCK)[:, None]
    sj = jnp.arange(2 * Q_BLOCK)[None, :]
    dist = (qi + Q_BLOCK - sj).astype(jnp.float32)
    key_pos = jnp.arange(nb)[:, None] * Q_BLOCK - Q_BLOCK + jnp.arange(2 * Q_BLOCK)[None, :]
    valid = ((dist >= 0) & (dist < WINDOW))[None] & (key_pos >= 0)[:, None, :]

    slopes = alibi_slopes(N_HEADS).reshape(N_KV_HEADS, GROUP)
    s = s - slopes[:, :, None, None] * dist
    s = jnp.where(valid[None, :, None, None], s, -jnp.inf)

    sink = sinks.astype(jnp.float32).reshape(N_KV_HEADS, GROUP)[None, None, :, :, None, None]
    m = jnp.maximum(jnp.max(s, axis=-1, keepdims=True), sink)
    p = jnp.exp(s - m)
    p = p / (jnp.sum(p, axis=-1, keepdims=True) + jnp.exp(sink - m))
    o = jnp.einsum("bnkgqs,bnskd->bnqkgd", p.astype(v.dtype), vb)
    return o.reshape(B, T, N_HEADS * HEAD_DIM)


def moe_ffn(h, w_router, b_router, w_gate, b_gate, w_up, b_up, w_down, b_down):
    B, T, D = h.shape
    N = B * T
    hf = h.reshape(N, D)
    logits = (hf @ w_router + b_router).astype(jnp.float32)
    top_v, top_e = lax.top_k(logits, TOP_K)
    top_w = jax.nn.softmax(top_v, axis=-1)

    A = N * TOP_K
    flat_e = top_e.reshape(A)
    flat_tok = jnp.repeat(jnp.arange(N, dtype=jnp.int32), TOP_K)
    flat_w = top_w.reshape(A)
    order = jnp.argsort(flat_e, stable=True)
    sorted_e = flat_e[order]
    counts = jnp.bincount(flat_e, length=N_EXPERTS)
    padded = ((counts + MOE_BLOCK - 1) // MOE_BLOCK) * MOE_BLOCK
    pad_end = jnp.cumsum(padded)
    pad_start = pad_end - padded
    start = jnp.cumsum(counts) - counts
    dest = pad_start[sorted_e] + jnp.arange(A) - start[sorted_e]

    n_blocks = (A + N_EXPERTS * (MOE_BLOCK - 1) + MOE_BLOCK - 1) // MOE_BLOCK
    P = n_blocks * MOE_BLOCK
    row_tok = jnp.zeros((P,), jnp.int32).at[dest].set(flat_tok[order])
    row_w = jnp.zeros((P,), jnp.float32).at[dest].set(flat_w[order])
    block_start = jnp.arange(n_blocks) * MOE_BLOCK
    block_e = jnp.minimum(jnp.sum(block_start[:, None] >= pad_end[None, :], axis=1), N_EXPERTS - 1)
    xb = hf[row_tok].reshape(n_blocks, MOE_BLOCK, D)

    def expert_block(args):
        xblk, e = args
        g = xblk @ w_gate[e] + b_gate[e]
        u = xblk @ w_up[e] + b_up[e]
        g = jnp.minimum(g, SWIGLU_LIMIT)
        u = jnp.clip(u, -SWIGLU_LIMIT, SWIGLU_LIMIT)
        a = (u + 1.0) * (g * jax.nn.sigmoid(SWIGLU_ALPHA * g))
        return a @ w_down[e] + b_down[e]

    yb = lax.map(expert_block, (xb, block_e)).reshape(P, D)
    y = jnp.zeros((N, D), jnp.float32).at[row_tok].add(yb.astype(jnp.float32) * row_w[:, None])
    return y.astype(h.dtype).reshape(B, T, D)


def setup_inputs(seed: int = 0) -> dict:
    key = jax.random.key(seed)
    ks = jax.random.split(key, 26)
    f = jnp.float32
    nrm = lambda k, shape, s: jax.random.normal(k, shape, f) * s
    D, F, E = D_MODEL, D_FF, N_EXPERTS
    return {
        "x": nrm(ks[0], (BATCH, SEQ, D), 1.0),
        "g_mix": 1.0 + nrm(ks[1], (D,), 0.05),
        "w_in": nrm(ks[2], (D, N_IN), D ** -0.5),
        "b_in": nrm(ks[3], (N_IN,), 0.02),
        "conv_w": nrm(ks[4], (K_CONV, C_CONV), K_CONV ** -0.5),
        "conv_b": nrm(ks[5], (C_CONV,), 0.02),
        "conv_ln_g": 1.0 + nrm(ks[6], (C_CONV,), 0.05),
        "conv_ln_b": nrm(ks[7], (C_CONV,), 0.02),
        "w_conv_out": nrm(ks[8], (C_CONV, D), C_CONV ** -0.5),
        "b_conv_out": nrm(ks[9], (D,), 0.02),
        "attn_sinks": nrm(ks[10], (N_HEADS,), 0.5),
        "w_attn_out": nrm(ks[11], (N_Q, D), N_Q ** -0.5),
        "b_attn_out": nrm(ks[12], (D,), 0.02),
        "w_out": nrm(ks[13], (D, D), D ** -0.5),
        "g_ffn": 1.0 + nrm(ks[14], (D,), 0.05),
        "w_router": nrm(ks[15], (D, E), D ** -0.5),
        "b_router": nrm(ks[16], (E,), 0.01),
        "w_gate": nrm(ks[17], (E, D, F), D ** -0.5),
        "b_gate": nrm(ks[18], (E, F), 0.02),
        "w_up": nrm(ks[19], (E, D, F), D ** -0.5),
        "b_up": nrm(ks[20], (E, F), 0.02),
        "w_down": nrm(ks[21], (E, F, D), F ** -0.5),
        "b_down": nrm(ks[22], (E, D), 0.02),
        "g_final": 1.0 + nrm(ks[23], (D,), 0.05),
    }


def reference(x, g_mix, w_in, b_in, conv_w, conv_b, conv_ln_g, conv_ln_b, w_conv_out,
              b_conv_out, attn_sinks, w_attn_out, b_attn_out, w_out, g_ffn, w_router,
              b_router, w_gate, b_gate, w_up, b_up, w_down, b_down, g_final):
    B, T, D = x.shape
    for _ in range(DEPTH):
        h = rms_norm(x, g_mix)
        z = h @ w_in + b_in
        o0 = 0
        glu_a = z[..., o0:o0 + C_CONV]; o0 += C_CONV
        glu_b = z[..., o0:o0 + C_CONV]; o0 += C_CONV
        q = z[..., o0:o0 + N_Q].reshape(B, T, N_HEADS, HEAD_DIM); o0 += N_Q
        k = z[..., o0:o0 + N_KV].reshape(B, T, N_KV_HEADS, HEAD_DIM); o0 += N_KV
        v = z[..., o0:o0 + N_KV].reshape(B, T, N_KV_HEADS, HEAD_DIM); o0 += N_KV
        gate_conv = jax.nn.sigmoid(z[..., o0:o0 + D]); o0 += D
        gate_attn = jax.nn.sigmoid(z[..., o0:o0 + D])

        y_conv = conformer_conv(glu_a, glu_b, conv_w, conv_b, conv_ln_g, conv_ln_b,
                                w_conv_out, b_conv_out)
        y_attn = sliding_window_attention(q, k, v, attn_sinks) @ w_attn_out + b_attn_out
        x = x + (gate_conv * y_conv + gate_attn * y_attn) @ w_out

        x = x + moe_ffn(rms_norm(x, g_ffn), w_router, b_router, w_gate, b_gate,
                        w_up, b_up, w_down, b_down)
    return rms_norm(x, g_final)
```

```cpp
#include <hip/hip_runtime.h>
#include <cstdio>
#include <cstdint>

#define LAS __attribute__((address_space(3)))
#define GAS __attribute__((address_space(1)))
typedef unsigned short bf16_t;
typedef short bf16x8 __attribute__((ext_vector_type(8)));
typedef short s16x4 __attribute__((ext_vector_type(4)));
typedef float f32x2 __attribute__((ext_vector_type(2)));
typedef float f32x4 __attribute__((ext_vector_type(4)));
typedef float f32x16 __attribute__((ext_vector_type(16)));
typedef unsigned u32x2 __attribute__((ext_vector_type(2)));
typedef unsigned u32x4 __attribute__((ext_vector_type(4)));
typedef GAS unsigned gu32;
typedef int i32x4 __attribute__((ext_vector_type(4)));
typedef int i32x8 __attribute__((ext_vector_type(8)));
constexpr float W8SCALE = 32.f;
constexpr int W8_MFMA_SCALE = 0x7a7a7a7a;
constexpr float CGATE = 1.702f * 1.4426950408889634f;

#ifndef MK_N_LAUNCHES
#define MK_N_LAUNCHES 1
#endif
#ifndef REP_EPI
#define REP_EPI 0
#endif
#ifndef REP_P0
#define REP_P0 1
#endif
#ifndef STAG_P1
#define STAG_P1 2
#endif
#ifndef REP_P8
#define REP_P8 1
#endif
#ifndef REP_CV
#define REP_CV 1
#endif
#ifndef REP_CONV
#define REP_CONV 1
#endif
#ifndef REP_NULL
#define REP_NULL 0
#endif
#ifndef REP_P1
#define REP_P1 1
#endif
#ifndef REP_CONV
#define REP_CONV 1
#endif
#ifndef REP_P3
#define REP_P3 1
#endif
#ifndef REP_P4
#define REP_P4 1
#endif
#ifndef REP_P5B
#define REP_P5B 1
#endif
#ifndef REP_P6
#define REP_P6 1
#endif
#ifndef REP_P7
#define REP_P7 1
#endif
constexpr int N_PHASES = 9;
constexpr int N_LAUNCHES = MK_N_LAUNCHES;

constexpr int BATCH = 8, SEQ = 4096, D = 1024, M = BATCH * SEQ, NIN = 5376, NE = 32, KCONV = 31;
constexpr float EPS = 1e-5f;
constexpr float LOG2E = 1.4426950408889634f;
constexpr float QSCALE = 0.125f * LOG2E;
constexpr int LIST_CAP = 32768;

constexpr size_t MiB = 1u << 20;
constexpr size_t WS_CTL = 0, CTL_ZERO_BYTES = 128 * 1024;
constexpr size_t WS_LIST = 1 * MiB;
constexpr size_t WS_TOKW = 5 * MiB;
constexpr size_t WS_RSTD1 = 5 * MiB + 512 * 1024;
constexpr size_t WS_RSTD2 = WS_RSTD1 + 128 * 1024;
constexpr size_t WS_BPERM = WS_RSTD2 + 128 * 1024;
constexpr size_t WS_WRT = 6 * MiB;
constexpr size_t WS_R1 = 7 * MiB;
constexpr size_t WS_U = WS_R1, WS_QO = WS_R1 + 64 * MiB, WS_KV = WS_R1 + 128 * MiB, WS_RR = WS_R1 + 144 * MiB, WS_GA = WS_R1 + 208 * MiB;
constexpr size_t WS_MIX = WS_U;
constexpr size_t WS_ACT = WS_R1;
constexpr size_t WS_X1F8 = WS_R1 + 136 * MiB;
constexpr size_t WS_Y = WS_R1 + 136 * MiB;
constexpr size_t WS_ROWOF = 6 * MiB + 256 * 1024;
constexpr size_t WS_R2 = 279 * MiB;
constexpr size_t WS_R4 = 343 * MiB;
constexpr size_t WS_WIN = 503 * MiB, WS_WCO = WS_WIN + 11 * MiB, WS_WAO = WS_WIN + 13 * MiB, WS_WO = WS_WIN + 15 * MiB;
constexpr size_t WS_WGU = WS_R4, WS_YB = WS_R4;
constexpr size_t WS_WD = 471 * MiB;
constexpr size_t WS_END = 535 * MiB;

constexpr int CW_BAR = 4096;
constexpr int CW_GCNT = 16384;

constexpr int RING_BYTES = 131072;
constexpr int MISC_OFF = RING_BYTES;
constexpr int MISC_XB = 0;
constexpr int MISC_CPRE = 64;
constexpr int MISC_TBL = 256;
constexpr int MISC_UTAB = 512;
constexpr int MISC_HIST = 512, MISC_SBASE = 640;
constexpr int MISC_ETAB = 1024, MISC_LTAB = 3072;
constexpr int MISC_IDX = 8192;
constexpr int IDX_SLOTS = 18;
constexpr int LDS_BYTES = RING_BYTES + 8192 + IDX_SLOTS * 1024;

#define RLX_AGENT __ATOMIC_RELAXED, __HIP_MEMORY_SCOPE_AGENT
#define LDS_WAIT() asm volatile("s_waitcnt lgkmcnt(0)" ::: "memory")
#define VM_WAIT() asm volatile("s_waitcnt vmcnt(0)" ::: "memory")
__device__ __forceinline__ unsigned cvt_pk_bf16(float lo, float hi) { unsigned r; asm volatile("v_cvt_pk_bf16_f32 %0, %1, %2" : "=v"(r) : "v"(lo), "v"(hi)); return r; }
__device__ __forceinline__ float bf_lo(unsigned w) { return __uint_as_float(w << 16); }
__device__ __forceinline__ float bf_hi(unsigned w) { return __uint_as_float(w & 0xffff0000u); }
__device__ __forceinline__ float fast_exp2(float x) { return __builtin_amdgcn_exp2f(x); }
__device__ __forceinline__ float fast_rcp(float x) { return __builtin_amdgcn_rcpf(x); }
__device__ __forceinline__ float sigmoid_f(float x) { return fast_rcp(1.f + fast_exp2(-LOG2E * x)); }
__device__ __forceinline__ float wave_sum(float v) {
#pragma unroll
    for (int o = 1; o < 64; o <<= 1) v += __shfl_xor(v, o);
    return v;
}
__device__ __forceinline__ float wave_max(float v) {
#pragma unroll
    for (int o = 1; o < 64; o <<= 1) v = fmaxf(v, __shfl_xor(v, o));
    return v;
}
__device__ __forceinline__ unsigned pack4_fp8(float a, float b, float c, float d) { int v = 0; v = __builtin_amdgcn_cvt_pk_fp8_f32(a, b, v, false); v = __builtin_amdgcn_cvt_pk_fp8_f32(c, d, v, true); return (unsigned)v; }
__device__ __forceinline__ u32x4 pack8(f32x4 a, f32x4 b) { u32x4 w; w.x = cvt_pk_bf16(a[0], a[1]); w.y = cvt_pk_bf16(a[2], a[3]); w.z = cvt_pk_bf16(b[0], b[1]); w.w = cvt_pk_bf16(b[2], b[3]); return w; }

#define XB_TMO      128
#define XB_XCNT(j)  (256  + 64 * (j))
#define XB_XSUB(j)  (1280 + 64 * (j))
#define XB_XGEN(j)  (2304 + 64 * (j))
#define XB_TOP      3328
#define XB_TOPGEN   3392
#define XCD_BAR_WORDS 3456
#define XB_SPIN_CAP (1u << 18)

__device__ __forceinline__ unsigned xb_ld(unsigned* p)              { return __hip_atomic_load(p, __ATOMIC_RELAXED, __HIP_MEMORY_SCOPE_AGENT); }
__device__ __forceinline__ unsigned xb_add(unsigned* p, unsigned v) { return __hip_atomic_fetch_add(p, v, __ATOMIC_RELAXED, __HIP_MEMORY_SCOPE_AGENT); }
__device__ __forceinline__ unsigned xb_xcc_id() { return (unsigned)__builtin_amdgcn_s_getreg((3 << 11) | 20) & 0xFu; }
#define XB_SPIN(cond, bar) do { unsigned _sp = 0; while (cond) { __builtin_amdgcn_s_sleep(1); \
    if ((++_sp & 255u) == 0u) { if (xb_ld(&(bar)[XB_TMO])) break; if (_sp > XB_SPIN_CAP) { atomicAdd(&(bar)[XB_TMO], 1u); break; } } } } while (0)

struct XcdBarrier { unsigned* bar; unsigned x; volatile LAS unsigned* st; };

__device__ __forceinline__ XcdBarrier xcd_barrier_post(unsigned* bar, volatile LAS unsigned* st) {
    XcdBarrier b; b.bar = bar; b.x = xb_xcc_id(); b.st = st;
    if (threadIdx.x == 0) (void)xb_add(&bar[XB_XCNT(b.x)], 1u);
    return b;
}
__device__ __forceinline__ void xcd_barrier_complete(unsigned* bar, unsigned x, unsigned& nloc, unsigned& nx) {
    const unsigned G = gridDim.x * gridDim.y * gridDim.z;
    unsigned sum, cnt, mine, sp = 0u;
    for (;;) {
        sum = 0u; cnt = 0u; mine = 0u;
#pragma unroll
        for (unsigned j = 0; j < 16; ++j) { const unsigned c = xb_ld(&bar[XB_XCNT(j)]); sum += c; cnt += (c > 0u) ? 1u : 0u; mine = (j == x) ? c : mine; }
        if (sum == G) break;
        __builtin_amdgcn_s_sleep(1);
        if ((++sp & 255u) == 0u) { if (xb_ld(&bar[XB_TMO])) break; if (sp > XB_SPIN_CAP) { atomicAdd(&bar[XB_TMO], 1u); break; } }
    }
    nloc = mine > 0u ? mine : 1u; nx = cnt > 0u ? cnt : 1u;
}
__device__ __forceinline__ void xcd_barrier(const XcdBarrier& b) {
    asm volatile("s_waitcnt vmcnt(0)" ::: "memory");
    __syncthreads();
    if (threadIdx.x == 0) {
        unsigned* bar = b.bar;
        __builtin_amdgcn_s_waitcnt(0);
        unsigned nloc = b.st[0], nx = b.st[1];
        if (nloc == 0u) { xcd_barrier_complete(bar, b.x, nloc, nx); b.st[0] = nloc; b.st[1] = nx; }
        const unsigned old = xb_add(&bar[XB_XSUB(b.x)], 1u);
        const unsigned gen = old / nloc;
        if (old + 1u == (gen + 1u) * nloc) {
            __builtin_amdgcn_fence(__ATOMIC_RELEASE, "agent");
            asm volatile("s_waitcnt vmcnt(0)" ::: "memory");
            const unsigned og = xb_add(&bar[XB_TOP], 1u);
            const unsigned tg = og / nx;
            if (og + 1u == (tg + 1u) * nx) xb_add(&bar[XB_TOPGEN], 1u);
            else XB_SPIN(xb_ld(&bar[XB_TOPGEN]) == tg, bar);
            __builtin_amdgcn_fence(__ATOMIC_ACQUIRE, "agent");
            xb_add(&bar[XB_XGEN(b.x)], 1u);
            asm volatile("s_waitcnt vmcnt(0)" ::: "memory");
        } else {
            XB_SPIN(xb_ld(&bar[XB_XGEN(b.x)]) == gen, bar);
            __builtin_amdgcn_fence(__ATOMIC_ACQUIRE, "agent");
            asm volatile("s_waitcnt vmcnt(0)" ::: "memory");
        }
    }
    __syncthreads();
}

namespace mg {
constexpr int BM = 256, BK = 64, HALF = 128, HTB = HALF * BK * 2, K = 1024, NXCD = 8, WGM = 8;
__host__ __device__ __forceinline__ int lds_byte(int r, int c) { const int st = (r >> 4) * 2 + (c >> 5), rr = r & 15, cc = c & 31, ob = rr * 64 + cc * 2; return st * 1024 + (ob ^ (((ob >> 9) & 1) << 5)); }
__host__ __device__ __forceinline__ void stage_rc(int b, int& R, int& C) { const int st = b / 1024, sb = b % 1024, swz = sb ^ (((sb >> 9) & 1) << 5); R = (st >> 1) * 16 + swz / 64; C = (st & 1) * 32 + (swz % 64) / 2; }
__host__ __device__ __forceinline__ int perm32(int rho) { const int n = rho >> 4, i = rho & 15; return 8 * (i >> 2) + 4 * n + (i & 3); }

struct GUnit { const char* A; const char* B; int slot, pm, pn, aux, lslot; };

struct StaticOrder {
    int nM, nN, nwg, G, c;
    __device__ void init(int M_, int N_, int G_, int c_) { nM = M_ / BM; nN = N_ / BM; nwg = nM * nN; G = G_; c = c_; }
    __device__ bool next(int i, int& pm, int& pn) const {
        const long L = (long)i * G + c; if (L >= nwg) return false;
        int wgid = (int)L; { const int q = nwg / NXCD, r = nwg % NXCD, xcd = wgid % NXCD, off = wgid / NXCD; wgid = (xcd < r ? xcd * (q + 1) : r * (q + 1) + (xcd - r) * q) + off; }
        const int nig = WGM * nN, gid = wgid / nig, fm = gid * WGM, gsz = (nM - fm) < WGM ? (nM - fm) : WGM;
        pm = fm + ((wgid % nig) % gsz); pn = (wgid % nig) / gsz; return true;
    }
};

template <int ROWB, bool GATHER> __device__ __forceinline__ void unit_offs(LAS unsigned char* lds, const GUnit& u, const int (&RA)[2], const int (&CA2)[2], unsigned (&o0)[2], unsigned (&o1)[2]) {
#pragma unroll
    for (int i = 0; i < 2; ++i) {
        int r0 = RA[i], r1 = HALF + RA[i];
        if constexpr (GATHER) { if (u.slot >= 0) { const LAS int* ix = (const LAS int*)(lds + MISC_OFF + MISC_IDX) + u.slot * 256; const int e0 = ix[r0], e1 = ix[r1]; r0 = e0 < 0 ? 0 : (e0 >> 2); r1 = e1 < 0 ? 0 : (e1 >> 2); } else { r0 += u.pm * 256; r1 += u.pm * 256; } }
        o0[i] = (unsigned)r0 * (unsigned)ROWB + (unsigned)CA2[i]; o1[i] = (unsigned)r1 * (unsigned)ROWB + (unsigned)CA2[i];
    }
}

template <class Epi, class Sched>
__device__ __forceinline__ void gemm_phase(LAS unsigned char* lds, const Sched& S, const Epi& E) {
    constexpr int ROWB = Epi::ROWB, NT = ROWB / 128; constexpr bool GATHER = Sched::GATHER;
    const int tid = threadIdx.x, wid = __builtin_amdgcn_readfirstlane(tid >> 6), lane = tid & 63, wr = wid >> 2, wc = wid & 3, fr = lane & 15, fq = lane >> 4;
    int RA[2], CA2[2]; unsigned voffB[2];
#pragma unroll
    for (int i = 0; i < 2; ++i) { int R, C; stage_rc(tid * 16 + i * 8192, R, C); const int Rb = (Epi::PERM64) ? (64 * (R >> 5) + 16 * ((R >> 2) & 3) + 4 * ((R >> 4) & 1) + (R & 3)) : Epi::PERM ? ((R & ~31) + perm32(R & 31)) : R;
        RA[i] = R; CA2[i] = C * 2; voffB[i] = (unsigned)(Rb * ROWB + C * 2); }
    constexpr size_t kstep = (size_t)(BK * 2);
    constexpr size_t hstepB = (size_t)(Epi::PERM64 ? 8 : HALF) * ROWB;
    const unsigned ldsw = (unsigned)wid * 1024u;
    const int aoff = lds_byte(wr * 64 + fr, fq * 8), boff = lds_byte(wc * 32 + fr, fq * 8);
#define MG_SA(b, h) (((b) * 2 + (h)) * HTB)
#define MG_SB(b, h) ((4 + (b) * 2 + (h)) * HTB)
#define MG_STAGE(bufoff, gbase, voff) do { _Pragma("unroll") for (int _i = 0; _i < 2; ++_i) \
        __builtin_amdgcn_global_load_lds((const unsigned*)((const char*)(gbase) + (voff)[_i]), (LAS unsigned*)(lds + (bufoff) + ldsw + _i * 8192), 16, 0, 0); } while (0)
#define MG_LDA(dst, b, h) do { _Pragma("unroll") for (int m = 0; m < 4; ++m) { const i32x4 lo_ = *(const LAS i32x4*)(lds + MG_SA(b, h) + aoff + m * 2048), hi_ = *(const LAS i32x4*)(lds + MG_SA(b, h) + aoff + m * 2048 + 1024); dst[m] = __builtin_shufflevector(lo_, hi_, 0, 1, 2, 3, 4, 5, 6, 7); } } while (0)
#define MG_LDB(dst, b, h) do { _Pragma("unroll") for (int n = 0; n < 2; ++n) { const i32x4 lo_ = *(const LAS i32x4*)(lds + MG_SB(b, h) + boff + n * 2048), hi_ = *(const LAS i32x4*)(lds + MG_SB(b, h) + boff + n * 2048 + 1024); dst[n] = __builtin_shufflevector(lo_, hi_, 0, 1, 2, 3, 4, 5, 6, 7); } } while (0)
#define MG_MMA(ai, bj, At, Bt) do { __builtin_amdgcn_s_setprio(1); _Pragma("unroll") for (int m = 0; m < 4; ++m) _Pragma("unroll") for (int n = 0; n < 2; ++n) { \
        if constexpr (Epi::F8) { acc[ai][bj][m][n] = __builtin_amdgcn_mfma_scale_f32_16x16x128_f8f6f4(Bt[n], At[m], acc[ai][bj][m][n], 0, 0, 0, W8_MFMA_SCALE, 0, 0x7f7f7f7f); } \
        else { acc[ai][bj][m][n] = __builtin_amdgcn_mfma_f32_16x16x32_bf16(__builtin_bit_cast(bf16x8, __builtin_shufflevector(Bt[n], Bt[n], 0, 1, 2, 3)), __builtin_bit_cast(bf16x8, __builtin_shufflevector(At[m], At[m], 0, 1, 2, 3)), acc[ai][bj][m][n], 0, 0, 0); \
               acc[ai][bj][m][n] = __builtin_amdgcn_mfma_f32_16x16x32_bf16(__builtin_bit_cast(bf16x8, __builtin_shufflevector(Bt[n], Bt[n], 4, 5, 6, 7)), __builtin_bit_cast(bf16x8, __builtin_shufflevector(At[m], At[m], 4, 5, 6, 7)), acc[ai][bj][m][n], 0, 0, 0); } } \
        __builtin_amdgcn_s_setprio(0); } while (0)
#define MG_WAIT_V(n) asm volatile("s_waitcnt vmcnt(" #n ")" ::: "memory")
#define MG_WAIT_L(n) asm volatile("s_waitcnt lgkmcnt(" #n ")" ::: "memory")
#define MG_BAR __builtin_amdgcn_s_barrier()
#define MG_SCHED __builtin_amdgcn_sched_barrier(0)
    GUnit cur, nxt; int ui = 0;
    if (!S.next(0, cur)) return;
    f32x4 acc[2][2][4][2];
    E.init(acc, cur, wr, wc, fr, fq);
    i32x8 At[4], B0[2], B1[2];
    unsigned cA0[2], cA1[2];
    unit_offs<ROWB, GATHER>(lds, cur, RA, CA2, cA0, cA1);
    const char* cAp = cur.A; const char* cBp = cur.B;
    MG_STAGE(MG_SB(0, 0), cBp, voffB); MG_STAGE(MG_SB(0, 1), cBp + hstepB, voffB); MG_STAGE(MG_SA(0, 0), cAp, cA0); MG_STAGE(MG_SA(0, 1), cAp, cA1);
    if (wr == 1) MG_BAR;
    MG_WAIT_V(2); MG_BAR;
    MG_STAGE(MG_SB(1, 0), cBp + kstep, voffB); MG_STAGE(MG_SA(1, 0), cAp + kstep, cA0); MG_STAGE(MG_SB(1, 1), cBp + hstepB + kstep, voffB);
    MG_WAIT_V(6); MG_BAR;
    for (;;) {
        const bool has_next = S.next(ui + 1, nxt);
        const char* nAp = has_next ? nxt.A : cAp; const char* nBp = has_next ? nxt.B : cBp;
#pragma unroll 1
        for (int t = 0; t < NT; t += 2) {
            const bool last = (t == NT - 2);
            const char* a1 = cAp + (size_t)(t + 1) * kstep;
            const char* a2 = last ? nAp : cAp + (size_t)(t + 2) * kstep; const char* b2 = last ? nBp : cBp + (size_t)(t + 2) * kstep;
            const char* a3 = a2 + kstep; const char* b3 = b2 + kstep;
            MG_LDB(B0, 0, 0); MG_LDB(B1, 0, 1); MG_SCHED; MG_LDA(At, 0, 0); MG_STAGE(MG_SA(1, 1), a1, cA1);
            if constexpr (GATHER) { if (last && has_next) unit_offs<ROWB, GATHER>(lds, nxt, RA, CA2, cA0, cA1); }
            MG_WAIT_V(8); MG_WAIT_L(0); MG_BAR; MG_MMA(0, 0, At, B0); MG_MMA(0, 1, At, B1); MG_BAR; MG_SCHED;
            MG_LDA(At, 0, 1); MG_STAGE(MG_SB(0, 0), b2, voffB); MG_STAGE(MG_SB(0, 1), b2 + hstepB, voffB); MG_STAGE(MG_SA(0, 0), a2, cA0);
            MG_WAIT_V(8); MG_WAIT_L(0); MG_BAR; MG_MMA(1, 0, At, B0); MG_MMA(1, 1, At, B1); MG_BAR; MG_SCHED;
            MG_LDB(B0, 1, 0); MG_LDB(B1, 1, 1); MG_SCHED; MG_LDA(At, 1, 0); MG_STAGE(MG_SA(0, 1), a2, cA1);
            MG_WAIT_V(8); MG_WAIT_L(0); MG_BAR; MG_MMA(0, 0, At, B0); MG_MMA(0, 1, At, B1); MG_BAR; MG_SCHED;
            MG_LDA(At, 1, 1); MG_STAGE(MG_SB(1, 0), b3, voffB); MG_STAGE(MG_SB(1, 1), b3 + hstepB, voffB); MG_STAGE(MG_SA(1, 0), a3, cA0);
            MG_WAIT_V(8); MG_WAIT_L(0); MG_BAR; MG_MMA(1, 0, At, B0); MG_MMA(1, 1, At, B1); MG_BAR; MG_SCHED;
        }
        if (wr == 0) MG_BAR;
        E(acc, cur, nxt, has_next, wr, wc, fr, fq);
        if (!has_next) break;
        cur = nxt; cAp = nAp; cBp = nBp; ++ui;
        if (wr == 1) MG_BAR;
    }
    MG_WAIT_V(0);
    MG_BAR;
#undef MG_SA
#undef MG_SB
#undef MG_STAGE
#undef MG_LDA
#undef MG_LDB
#undef MG_MMA
#undef MG_WAIT_V
#undef MG_WAIT_L
#undef MG_BAR
#undef MG_SCHED
}

template <int ROWB = 2048> struct DenseSched {
    static constexpr bool GATHER = (ROWB == 1024);
    StaticOrder so; const char* A; const char* Bt;
    __device__ __forceinline__ bool next(int i, GUnit& u) const {
        int pm, pn; if (!so.next(i, pm, pn)) return false;
        u.A = GATHER ? A : A + (size_t)pm * (256 * ROWB); u.B = Bt + (size_t)pn * (256 * ROWB); u.slot = GATHER ? -1 : 0; u.lslot = 0; u.pm = pm; u.pn = pn; u.aux = 0; return true;
    }
};
struct MixSched {
    static constexpr bool GATHER = false;
    StaticOrder so; const char* A0; const char* A1; const char* B0; const char* B1;
    __device__ __forceinline__ bool next(int s, GUnit& u) const {
        int pm, pn; if (!so.next(s >> 1, pm, pn)) return false;
        const int part = s & 1;
        u.A = (part ? A1 : A0) + (size_t)pm * (256 * K * 2); u.B = (part ? B1 : B0) + (size_t)pn * (256 * K * 2); u.slot = 0; u.lslot = 0; u.pm = pm; u.pn = pn; u.aux = part; return true;
    }
};
template <int NCOL, bool GATHER_, int ROWB> struct MoeSched {
    static constexpr bool GATHER = true;
    const LAS int* tbl; int j, G; const char* A; const char* Bt; const int* list;
    __device__ __forceinline__ void preload(LAS unsigned char* lds, int tid) const {
        LAS int* ut = (LAS int*)(lds + MISC_OFF + MISC_UTAB);
        if (tid < IDX_SLOTS) {
            const int total = tbl[NE] * NCOL, Lg = tid * G + j; int e = -1, lrt = 0, rt = 0, pn = 0;
            if (Lg < total) { rt = Lg / NCOL; pn = Lg % NCOL; e = 0; for (int q = 1; q < NE; ++q) e += (tbl[q] <= rt) ? 1 : 0; lrt = rt - tbl[e]; }
            ut[tid * 4 + 0] = e; ut[tid * 4 + 1] = lrt; ut[tid * 4 + 2] = rt; ut[tid * 4 + 3] = pn;
        }
        LDS_WAIT(); __syncthreads();
        LAS int* ix = (LAS int*)(lds + MISC_OFF + MISC_IDX);
        if (GATHER_ && tid < 256) { int vals[IDX_SLOTS];
#pragma unroll
            for (int i = 0; i < IDX_SLOTS; ++i) { const int e = ut[i * 4], pos = ut[i * 4 + 1] * 256 + tid;
                const LAS int* cp_ = (const LAS int*)(lds + MISC_OFF + MISC_CPRE);
                const bool ok = (e >= 0) && (pos < cp_[(e < 0 ? 0 : e) + 1] - cp_[e < 0 ? 0 : e]);
                vals[i] = ok ? list[(size_t)(e < 0 ? 0 : e) * LIST_CAP + pos] : -1; }
#pragma unroll
            for (int i = 0; i < IDX_SLOTS; ++i) ix[i * 256 + tid] = vals[i]; }
        LDS_WAIT(); __syncthreads();
    }
    __device__ __forceinline__ bool next(int i, GUnit& u) const {
        if (i >= IDX_SLOTS) return false;
        const LAS int* ut = (const LAS int*)(tbl) + (MISC_UTAB - MISC_TBL) / 4 + i * 4;
        const int e = __builtin_amdgcn_readfirstlane(ut[0]); if (e < 0) return false;
        const int rt = __builtin_amdgcn_readfirstlane(ut[2]), pn = __builtin_amdgcn_readfirstlane(ut[3]);
        u.A = A; u.B = Bt + ((size_t)e * NCOL + pn) * (256 * ROWB);
        u.slot = GATHER_ ? i : -1; u.lslot = i; u.pm = rt; u.pn = pn; u.aux = e; return true;
    }
};

#define FOR_AI_M _Pragma("unroll") for (int ai = 0; ai < 2; ++ai) _Pragma("unroll") for (int m = 0; m < 4; ++m)
#define FOR_BJ_N _Pragma("unroll") for (int bj = 0; bj < 2; ++bj) _Pragma("unroll") for (int n = 0; n < 2; ++n)
__device__ __forceinline__ void acc_fill(f32x4 (&acc)[2][2][4][2], const f32x4 (&bv)[2][2]) { FOR_AI_M { FOR_BJ_N acc[ai][bj][m][n] = bv[bj][n]; } }
template <bool ST> struct EpiInT {
    static constexpr bool PERM = true, PERM64 = false, F8 = true; static constexpr int ROWB = 1024, ID = 1;
    const float* bperm; bf16_t *U, *Q, *KV, *RR, *GA; int opq;
    __device__ __forceinline__ void load_bias(f32x4 (&bv)[2][2], int pn, int wc, int fq) const { const int cw = wc * 32 + 8 * fq; FOR_BJ_N bv[bj][n] = *(const f32x4*)(bperm + pn * 256 + bj * 128 + cw + 4 * n); }
    __device__ __forceinline__ void init(f32x4 (&acc)[2][2][4][2], const GUnit& u, int wr, int wc, int fr, int fq) const { f32x4 bv[2][2]; load_bias(bv, u.pn, wc, fq); acc_fill(acc, bv); }
    __device__ __forceinline__ void operator()(f32x4 (&acc)[2][2][4][2], const GUnit& u, const GUnit& nx, bool has_next, int wr, int wc, int fr, int fq) const {
        const int pn = u.pn, row0 = u.pm * 256 + wr * 64 + fr, cw = wc * 32 + 8 * fq;
        f32x4 nb[2][2]; load_bias(nb, has_next ? nx.pn : pn, wc, fq);
        const size_t gbase = ((size_t)(u.pm * 8 + (pn - 13)) * 64 + (size_t)((wr * 4 + wc) * 8)) * 512 + (size_t)(fq * 16 + fr) * 8;
        FOR_AI_M {
            const int row = row0 + ai * 128 + m * 16;
            if (pn < 8) {
                f32x4 r[2];
#pragma unroll
                for (int n = 0; n < 2; ++n) { const f32x4 a = acc[ai][0][m][n], b = acc[ai][1][m][n]; f32x4 e;
#pragma unroll
                    for (int j = 0; j < 4; ++j) e[j] = fast_exp2(-b[j]);
                    e = e + 1.f;
#pragma unroll
                    for (int j = 0; j < 4; ++j) e[j] = fast_rcp(e[j]);
                    r[n] = a * e; }
                { const u32x4 pk = pack8(r[0], r[1]); if constexpr (!ST) asm volatile("" :: "v"(pk)); if (ST || opq) *(u32x4*)(U + (size_t)row * D + pn * 128 + cw) = pk; }
            } else if (pn < 12) {
#pragma unroll
                for (int bj = 0; bj < 2; ++bj) { const u32x4 pk = pack8(acc[ai][bj][m][0], acc[ai][bj][m][1]); if constexpr (!ST) asm volatile("" :: "v"(pk)); if (ST || opq) *(u32x4*)(Q + (size_t)row * D + (pn - 8) * 256 + bj * 128 + cw) = pk; }
            } else if (pn == 12) {
#pragma unroll
                for (int bj = 0; bj < 2; ++bj) { const u32x4 pk = pack8(acc[ai][bj][m][0], acc[ai][bj][m][1]); if constexpr (!ST) asm volatile("" :: "v"(pk)); if (ST || opq) *(u32x4*)(KV + (size_t)row * 256 + bj * 128 + cw) = pk; }
            } else {
                f32x4 rr[2], ga[2];
#pragma unroll
                for (int n = 0; n < 2; ++n) {
                    f32x4 ea, eb;
#pragma unroll
                    for (int j = 0; j < 4; ++j) { ea[j] = fast_exp2(-__builtin_amdgcn_fmed3f(acc[ai][0][m][n][j], -60.f, 60.f)); eb[j] = fast_exp2(-__builtin_amdgcn_fmed3f(acc[ai][1][m][n][j], -60.f, 60.f)); }
                    ea = ea + 1.f; eb = eb + 1.f;
                    f32x4 ia, ib;
#pragma unroll
                    for (int j = 0; j < 4; ++j) { ia[j] = fast_rcp(ea[j]); ib[j] = fast_rcp(eb[j]); }
                    ga[n] = ib; rr[n] = eb * ia;
                }
                const size_t o = gbase + (size_t)((ai * 4 + m) * 512);
                { const u32x4 p0 = pack8(rr[0], rr[1]), p1 = pack8(ga[0], ga[1]); if constexpr (!ST) asm volatile("" :: "v"(p0), "v"(p1)); if (ST || opq) { __builtin_nontemporal_store(p0, (u32x4*)(RR + o)); __builtin_nontemporal_store(p1, (u32x4*)(GA + o)); } }
            }
            FOR_BJ_N acc[ai][bj][m][n] = nb[bj][n];
        }
    }
};
using EpiIn = EpiInT<true>;
struct EpiMix {
    static constexpr bool PERM = true, PERM64 = false, F8 = false; static constexpr int ROWB = 2048, ID = 3;
    const bf16_t *RR, *GA; const float *bco, *bao; bf16_t* MIX;
    __device__ __forceinline__ void load_bias(f32x4 (&bv)[2][2], const float* bias, int pn, int wc, int fq) const { const int c0 = pn * 256 + wc * 32 + 8 * fq; FOR_BJ_N bv[bj][n] = *(const f32x4*)(bias + c0 + bj * 128 + 4 * n); }
    __device__ __forceinline__ void init(f32x4 (&acc)[2][2][4][2], const GUnit& u, int wr, int wc, int fr, int fq) const { f32x4 bv[2][2]; load_bias(bv, bco, u.pn, wc, fq); acc_fill(acc, bv); }
    __device__ __forceinline__ void operator()(f32x4 (&acc)[2][2][4][2], const GUnit& u, const GUnit& nx, bool has_next, int wr, int wc, int fr, int fq) const {
        const int row0 = u.pm * 256 + wr * 64 + fr, col0 = u.pn * 256 + wc * 32 + 8 * fq;
        const bool part1 = (u.aux != 0);
        f32x4 nb[2][2]; load_bias(nb, part1 ? bco : bao, part1 ? (has_next ? nx.pn : u.pn) : u.pn, wc, fq);
        const bf16_t* Gb = (part1 ? GA : RR) + ((size_t)(u.pm * 8 + 2 * u.pn) * 64 + (size_t)((wr * 4 + wc) * 8)) * 512 + (size_t)(fq * 16 + fr) * 8;
        u32x4 gt[2][4][2];
        FOR_AI_M {
#pragma unroll
            for (int bj = 0; bj < 2; ++bj) gt[ai][m][bj] = __builtin_nontemporal_load((const u32x4*)(Gb + (size_t)(bj * 32768 + (ai * 4 + m) * 512))); }
        FOR_AI_M {
            const size_t ro = (size_t)(row0 + ai * 128 + m * 16) * D + col0;
#pragma unroll
            for (int bj = 0; bj < 2; ++bj) {
                const u32x4 g = gt[ai][m][bj];
                const f32x4 g0 = (f32x4){bf_lo(g.x), bf_hi(g.x), bf_lo(g.y), bf_hi(g.y)}, g1 = (f32x4){bf_lo(g.z), bf_hi(g.z), bf_lo(g.w), bf_hi(g.w)};
                if (part1) { *(u32x4*)(MIX + ro + bj * 128) = pack8(acc[ai][bj][m][0] * g0, acc[ai][bj][m][1] * g1); acc[ai][bj][m][0] = nb[bj][0]; acc[ai][bj][m][1] = nb[bj][1]; }
                else { acc[ai][bj][m][0] = acc[ai][bj][m][0] * g0 + nb[bj][0]; acc[ai][bj][m][1] = acc[ai][bj][m][1] * g1 + nb[bj][1]; }
            }
        }
    }
};
struct EpiRes {
    static constexpr bool PERM = true, PERM64 = false, F8 = false; static constexpr int ROWB = 2048, ID = 4;
    const float* x; bf16_t* X1B;
    __device__ __forceinline__ void init(f32x4 (&acc)[2][2][4][2], const GUnit& u, int wr, int wc, int fr, int fq) const { FOR_AI_M { FOR_BJ_N acc[ai][bj][m][n] = (f32x4){0.f, 0.f, 0.f, 0.f}; } }
    __device__ __forceinline__ void operator()(f32x4 (&acc)[2][2][4][2], const GUnit& u, const GUnit& nx, bool has_next, int wr, int wc, int fr, int fq) const {
        const int row0 = u.pm * 256 + wr * 64 + fr, col0 = u.pn * 256 + wc * 32 + 8 * fq;
#pragma unroll
        for (int ai = 0; ai < 2; ++ai) {
            f32x4 xt[4][2][2];
#pragma unroll
            for (int m = 0; m < 4; ++m) { const size_t ro = (size_t)(row0 + ai * 128 + m * 16) * D + col0;
#pragma unroll
                for (int bj = 0; bj < 2; ++bj) { xt[m][bj][0] = __builtin_nontemporal_load((const f32x4*)(x + ro + bj * 128)); xt[m][bj][1] = __builtin_nontemporal_load((const f32x4*)(x + ro + bj * 128 + 4)); } }
#pragma unroll
            for (int m = 0; m < 4; ++m) { const size_t ro = (size_t)(row0 + ai * 128 + m * 16) * D + col0;
#pragma unroll
                for (int bj = 0; bj < 2; ++bj) {
                    *(u32x4*)(X1B + ro + bj * 128) = pack8(xt[m][bj][0] + acc[ai][bj][m][0], xt[m][bj][1] + acc[ai][bj][m][1]);
                    acc[ai][bj][m][0] = (f32x4){0.f, 0.f, 0.f, 0.f}; acc[ai][bj][m][1] = (f32x4){0.f, 0.f, 0.f, 0.f};
                } }
        }
    }
};
struct EpiSwiglu {
    static constexpr bool PERM = true, PERM64 = false, F8 = true; static constexpr int ROWB = 1024, ID = 6;
    const float *bg, *bu; unsigned char* ACT;
    __device__ __forceinline__ void load_bias(f32x4 (&bv)[2][2], int e, int pn, int wc, int fq) const { const int ch0 = pn * 128 + wc * 32 + 8 * fq;
#pragma unroll
        for (int n = 0; n < 2; ++n) { bv[0][n] = *(const f32x4*)(bg + e * D + ch0 + 4 * n) * CGATE; bv[1][n] = *(const f32x4*)(bu + e * D + ch0 + 4 * n) + 1.f; } }
    __device__ __forceinline__ void init(f32x4 (&acc)[2][2][4][2], const GUnit& u, int wr, int wc, int fr, int fq) const { f32x4 bv[2][2]; load_bias(bv, u.aux, u.pn, wc, fq); acc_fill(acc, bv); }
    __device__ __forceinline__ void operator()(f32x4 (&acc)[2][2][4][2], const GUnit& u, const GUnit& nx, bool has_next, int wr, int wc, int fr, int fq) const {
        const int ch0 = u.pn * 128 + wc * 32 + 8 * fq;
        f32x4 nb[2][2]; load_bias(nb, has_next ? nx.aux : u.aux, has_next ? nx.pn : u.pn, wc, fq);
        constexpr float GLIM = 7.f * CGATE;
        FOR_AI_M {
            const int r = ai * 128 + wr * 64 + m * 16 + fr;
            f32x4 a[2];
#pragma unroll
            for (int n = 0; n < 2; ++n) {
                f32x4 gc, uc, e, d;
#pragma unroll
                for (int j = 0; j < 4; ++j) { gc[j] = __builtin_amdgcn_fmed3f(acc[ai][0][m][n][j], -3.0e38f, GLIM); uc[j] = __builtin_amdgcn_fmed3f(acc[ai][1][m][n][j], -6.f, 8.f); }
#pragma unroll
                for (int j = 0; j < 4; ++j) e[j] = fast_exp2(-gc[j]);
                d = e * CGATE + CGATE;
#pragma unroll
                for (int j = 0; j < 4; ++j) d[j] = fast_rcp(d[j]);
                a[n] = (uc * gc) * d;
            }
            u32x2 pk; pk.x = pack4_fp8(a[0][0], a[0][1], a[0][2], a[0][3]); pk.y = pack4_fp8(a[1][0], a[1][1], a[1][2], a[1][3]);
            *(u32x2*)(ACT + (size_t)(u.pm * 256 + r) * D + ch0) = pk;
            FOR_BJ_N acc[ai][bj][m][n] = nb[bj][n];
        }
    }
};
struct EpiDown {
    static constexpr bool PERM = true, PERM64 = true, F8 = true; static constexpr int ROWB = 1024, ID = 7, NST = 0;
    const LAS int* misc; const float* bd; unsigned char* Y;
    __device__ __forceinline__ void load_bias(f32x4 (&bv)[2][2], int e, int pn, int wc, int fq) const { const int c0 = pn * 256 + wc * 64 + 16 * fq; FOR_BJ_N bv[bj][n] = *(const f32x4*)(bd + e * D + c0 + 8 * bj + 4 * n); }
    __device__ __forceinline__ void init(f32x4 (&acc)[2][2][4][2], const GUnit& u, int wr, int wc, int fr, int fq) const { f32x4 bv[2][2]; load_bias(bv, u.aux, u.pn, wc, fq); acc_fill(acc, bv); }
    __device__ __forceinline__ void operator()(f32x4 (&acc)[2][2][4][2], const GUnit& u, const GUnit& nx, bool has_next, int wr, int wc, int fr, int fq) const {
        const int col0 = u.pn * 256 + wc * 64 + 16 * fq;
        const int c0 = __builtin_amdgcn_readfirstlane(misc[MISC_CPRE / 4 + u.aux]), c1 = __builtin_amdgcn_readfirstlane(misc[MISC_CPRE / 4 + u.aux + 1]);
        const int lr0 = 256 * __builtin_amdgcn_readfirstlane(misc[MISC_UTAB / 4 + u.lslot * 4 + 1]);
        const int drow0 = c0 + lr0, nvalid = c1 - c0 - lr0;
        f32x4 nb[2][2]; load_bias(nb, has_next ? nx.aux : u.aux, has_next ? nx.pn : u.pn, wc, fq);
        FOR_AI_M {
            const int r = ai * 128 + wr * 64 + m * 16 + fr;
            const int drow = (r < nvalid) ? drow0 + r : 4 * M;
            u32x4 pk;
#pragma unroll
            for (int bj = 0; bj < 2; ++bj) { const f32x4 v0 = acc[ai][bj][m][0], v1 = acc[ai][bj][m][1];
                pk[2 * bj] = pack4_fp8(v0[0], v0[1], v0[2], v0[3]); pk[2 * bj + 1] = pack4_fp8(v1[0], v1[1], v1[2], v1[3]); }
            *(u32x4*)(Y + (size_t)drow * 1024 + col0) = pk;
            FOR_BJ_N acc[ai][bj][m][n] = nb[bj][n];
        }
    }
};
template <class B> struct EpiNull {
    static constexpr bool PERM = B::PERM, PERM64 = B::PERM64, F8 = B::F8; static constexpr int ROWB = B::ROWB, ID = B::ID;
    B b;
    __device__ __forceinline__ void init(f32x4 (&acc)[2][2][4][2], const GUnit& u, int wr, int wc, int fr, int fq) const { b.init(acc, u, wr, wc, fr, fq); }
    __device__ __forceinline__ void operator()(f32x4 (&acc)[2][2][4][2], const GUnit& u, const GUnit& nx, bool has_next, int wr, int wc, int fr, int fq) const {
        FOR_AI_M { FOR_BJ_N asm volatile("" :: "v"(acc[ai][bj][m][n])); }
        b.init(acc, has_next ? nx : u, wr, wc, fr, fq);
    }
};
#undef FOR_AI_M
#undef FOR_BJ_N
}

struct Args { const float* in[24]; float* out; unsigned char* ws; int ph_lo, ph_hi, li, pad; };
enum { I_X = 0, I_GMIX, I_WIN, I_BIN, I_CONVW, I_CONVB, I_LNG, I_LNB, I_WCO, I_BCO, I_SINKS, I_WAO, I_BAO, I_WOUT, I_GFFN, I_WR, I_BR, I_WG, I_BG, I_WU, I_BU, I_WD, I_BD, I_GFIN };

__device__ __forceinline__ void tr_item(const float* W, int ldw, int k0, int scol0, const float* gscale, bf16_t* WT, int drow0, LAS float* scr, int lane) {
    const int kr = lane >> 3, nc = lane & 7;
#pragma unroll
    for (int it = 0; it < 8; ++it) {
        const int kk = 8 * it + kr; const f32x4 v = __builtin_nontemporal_load((const f32x4*)(W + (size_t)(k0 + kk) * ldw + scol0 + 4 * nc));
        const float g = gscale ? gscale[k0 + kk] : 1.f;
        LAS float* s = scr + kk * 33 + 4 * nc; s[0] = v[0] * g; s[1] = v[1] * g; s[2] = v[2] * g; s[3] = v[3] * g;
    }
    LDS_WAIT(); asm volatile("" ::: "memory");
    const int c = lane & 7;
#pragma unroll
    for (int j = 0; j < 4; ++j) { const int n = (lane >> 3) + 8 * j; const LAS float* s = scr + (8 * c) * 33 + n;
        u32x4 o; o.x = cvt_pk_bf16(s[0 * 33], s[1 * 33]); o.y = cvt_pk_bf16(s[2 * 33], s[3 * 33]); o.z = cvt_pk_bf16(s[4 * 33], s[5 * 33]); o.w = cvt_pk_bf16(s[6 * 33], s[7 * 33]);
        __builtin_nontemporal_store(o, (u32x4*)(WT + (size_t)(drow0 + n) * D + k0 + 8 * c)); }
    LDS_WAIT(); asm volatile("" ::: "memory");
}
struct TrSrc { const float* W; unsigned char* WT; int ldw, k0, scol0, drow0; float cs; };
__device__ __forceinline__ void tr_load(const TrSrc& t, f32x4 (&v)[8], int lane) {
    const int kr = lane >> 3, nc = lane & 7;
#pragma unroll
    for (int it = 0; it < 8; ++it) v[it] = __builtin_nontemporal_load((const f32x4*)(t.W + (size_t)(t.k0 + 8 * it + kr) * t.ldw + t.scol0 + 4 * nc));
}
__device__ __forceinline__ void tr_store_f8(const TrSrc& t, const f32x4 (&v)[8], LAS float* scr, int lane) {
    const int kr = lane >> 3, nc = lane & 7;
#pragma unroll
    for (int it = 0; it < 8; ++it) { const int kk = 8 * it + kr; LAS float* sp = scr + kk * 33 + 4 * nc; sp[0] = v[it][0]; sp[1] = v[it][1]; sp[2] = v[it][2]; sp[3] = v[it][3]; }
    LDS_WAIT(); asm volatile("" ::: "memory");
    const int c = lane & 7; const float cs = t.cs;
#pragma unroll
    for (int j = 0; j < 4; ++j) { const int n = (lane >> 3) + 8 * j; const LAS float* sp = scr + (8 * c) * 33 + n;
        const f32x4 a = (f32x4){sp[0 * 33], sp[1 * 33], sp[2 * 33], sp[3 * 33]} * cs, b = (f32x4){sp[4 * 33], sp[5 * 33], sp[6 * 33], sp[7 * 33]} * cs;
        u32x2 o; o.x = pack4_fp8(a[0], a[1], a[2], a[3]); o.y = pack4_fp8(b[0], b[1], b[2], b[3]);
        *(u32x2*)(t.WT + (size_t)(t.drow0 + n) * D + t.k0 + 8 * c) = o; }
    LDS_WAIT(); asm volatile("" ::: "memory");
}
__device__ __forceinline__ void tr_item_f8(const float* W, int ldw, int k0, int scol0, unsigned char* WT, int drow0, float cs, LAS float* scr, int lane) {
    TrSrc t{W, WT, ldw, k0, scol0, drow0, cs}; f32x4 v[8]; tr_load(t, v, lane); tr_store_f8(t, v, scr, lane);
}
__device__ __forceinline__ int win_src_col(int np) {
    const int pn = np >> 8, j = np & 255;
    if (pn < 8) { const int ch = 128 * pn + (j & 127); return (j < 128) ? ch : 1024 + ch; }
    if (pn < 13) return np;
    const int ch = 128 * (pn - 13) + (j & 127); return (j < 128) ? 3328 + ch : 4352 + ch;
}

__device__ __forceinline__ float win_col_scale(int np) {
    const int pn = np >> 8, j = np & 255;
    if (pn < 8) return (j < 128) ? 1.f : LOG2E;
    if (pn < 12) return QSCALE;
    if (pn == 12) return 1.f;
    return LOG2E;
}

__device__ __forceinline__ void p0_prologue(const Args& args, LAS unsigned char* lds, int vcu, int G, int wave, int lane) {
    unsigned char* ws = args.ws;
    LAS float* scr = (LAS float*)(lds + wave * 16384);
    const int gw = vcu * 8 + wave, NGW = G * 8;
    {
        const float* x = args.in[I_X]; unsigned char* XF8 = ws + WS_R2;
        f32x4 gm[4];
#pragma unroll
        for (int j = 0; j < 4; ++j) gm[j] = *((const f32x4*)args.in[I_GMIX] + lane + 64 * j);
        for (int m0 = gw; m0 < M; m0 += 4 * NGW) {
            f32x4 v[4][4];
#pragma unroll
            for (int q = 0; q < 4; ++q) { const int m = m0 + q * NGW; if (m < M) { const f32x4* xr = (const f32x4*)(x + (size_t)m * D) + lane;
#pragma unroll
                for (int j = 0; j < 4; ++j) v[q][j] = __builtin_nontemporal_load(xr + 64 * j); } }
#pragma unroll
            for (int q = 0; q < 4; ++q) { const int m = m0 + q * NGW; if (m < M) {
                float s = 0.f;
#pragma unroll
                for (int j = 0; j < 4; ++j) s += (v[q][j][0] * v[q][j][0] + v[q][j][1] * v[q][j][1]) + (v[q][j][2] * v[q][j][2] + v[q][j][3] * v[q][j][3]);
                s = wave_sum(s);
                unsigned* o = (unsigned*)(XF8 + (size_t)m * D) + lane;
                const float rs = 1.0f / sqrtf(s * (1.f / D) + EPS);
#pragma unroll
                for (int j = 0; j < 4; ++j) { const f32x4 t = v[q][j] * rs * gm[j]; o[64 * j] = pack4_fp8(t[0], t[1], t[2], t[3]); } } }
        }
    }
    {
        constexpr int I_IN = 16 * (NIN / 32), I_SQ = 16 * 32, NITEMS = I_IN + 3 * I_SQ;
        for (int it = gw; it < NITEMS; it += NGW) {
            int r = it;
            if (r < I_IN) { const int kb = r / (NIN / 32), db = r % (NIN / 32); tr_item_f8(args.in[I_WIN], NIN, 64 * kb, win_src_col(32 * db), ws + WS_WIN, 32 * db, W8SCALE * win_col_scale(32 * db), scr, lane); continue; }
            r -= I_IN;
            const int which = r / I_SQ; r -= which * I_SQ; const int kb = r / 32, db = r % 32;
            const float* W = which == 0 ? args.in[I_WCO] : which == 1 ? args.in[I_WAO] : args.in[I_WOUT];
            bf16_t* WT = (bf16_t*)(ws + (which == 0 ? WS_WCO : which == 1 ? WS_WAO : WS_WO));
            tr_item(W, D, 64 * kb, 32 * db, nullptr, WT, 32 * db, scr, lane);
        }
    }
    {
        const int gt = (vcu * 8 + wave) * 64 + lane, NT_ = G * 512;
        float* bperm = (float*)(ws + WS_BPERM); const float* b_in = args.in[I_BIN];
        for (int i = gt; i < NIN; i += NT_) bperm[i] = b_in[win_src_col(i)] * win_col_scale(i);
        { bf16_t* wrt = (bf16_t*)(ws + WS_WRT); const float* wr = args.in[I_WR]; const float* gf = args.in[I_GFFN];
          for (int i = gt; i < D * NE; i += NT_) { const int k = i >> 5, e = i & 31; wrt[e * D + k] = (bf16_t)(cvt_pk_bf16(wr[i] * gf[k], 0.f) & 0xffffu); } }
        int* list = (int*)(ws + WS_LIST);
    }
}
__device__ __forceinline__ TrSrc expert_half(const Args& args, int q, int h) {
    constexpr int P_GU = 8 * 64, PER_E = P_GU + 8 * 32;
    unsigned char* ws = args.ws;
    const int e = q / PER_E; int r = q % PER_E; TrSrc t;
    if (r < P_GU) { const int kp = r / 64, db = r % 64, np = 32 * db, pn = np >> 8, j = np & 255, ch = 128 * pn + (j & 127);
        t.W = ((j < 128) ? args.in[I_WG] : args.in[I_WU]) + (size_t)e * D * D; t.cs = (j < 128) ? W8SCALE * CGATE : W8SCALE; t.WT = ws + WS_WGU + (size_t)e * 2048 * D; t.ldw = D; t.k0 = 128 * kp + 64 * h; t.scol0 = ch; t.drow0 = np; }
    else { r -= P_GU; const int kp = r / 32, db = r % 32;
        t.W = args.in[I_WD] + (size_t)e * D * D; t.cs = W8SCALE; t.WT = ws + WS_WD + (size_t)e * D * D; t.ldw = D; t.k0 = 128 * kp + 64 * h; t.scol0 = 32 * db; t.drow0 = 32 * db; }
    return t;
}
__device__ __forceinline__ void tr_stage_f8(const TrSrc& t, const f32x4 (&v)[8], LAS float* scr, LAS unsigned char* img, int h, int lane) {
    const int kr = lane >> 3, nc = lane & 7;
#pragma unroll
    for (int it = 0; it < 8; ++it) { const int kk = 8 * it + kr; LAS float* sp = scr + kk * 33 + 4 * nc; sp[0] = v[it][0]; sp[1] = v[it][1]; sp[2] = v[it][2]; sp[3] = v[it][3]; }
    LDS_WAIT(); asm volatile("" ::: "memory");
    const int c = lane & 7; const float cs = t.cs;
#pragma unroll
    for (int j = 0; j < 4; ++j) { const int n = (lane >> 3) + 8 * j; const LAS float* sp = scr + (8 * c) * 33 + n;
        const f32x4 a = (f32x4){sp[0 * 33], sp[1 * 33], sp[2 * 33], sp[3 * 33]} * cs, b = (f32x4){sp[4 * 33], sp[5 * 33], sp[6 * 33], sp[7 * 33]} * cs;
        u32x2 o; o.x = pack4_fp8(a[0], a[1], a[2], a[3]); o.y = pack4_fp8(b[0], b[1], b[2], b[3]);
        *(LAS u32x2*)(img + n * 128 + h * 64 + 8 * c) = o; }
    LDS_WAIT(); asm volatile("" ::: "memory");
}
__device__ __forceinline__ void pair_flush(const TrSrc& t, const LAS unsigned char* img, int lane) {
#pragma unroll
    for (int j = 0; j < 4; ++j) { const int n = (lane >> 3) + 8 * j, pc = lane & 7;
        const u32x4 v = *(const LAS u32x4*)(img + n * 128 + 16 * pc);
        __builtin_nontemporal_store(v, (u32x4*)(t.WT + (size_t)(t.drow0 + n) * D + t.k0 + 16 * pc)); }
    LDS_WAIT(); asm volatile("" ::: "memory");
}
constexpr int CV_E0 = 4, CV_E1 = 8;
constexpr int CV_POOL0 = CV_E0 * 512, CV_POOL1 = CV_E1 * 256, CV_POOL2 = NE * 768 - CV_POOL0 - CV_POOL1;
__device__ __forceinline__ int pool_pair(int pool, int i) {
    if (pool == 0) return (i >> 9) * 768 + (i & 511);
    if (pool == 1) return (i >> 8) * 768 + 512 + (i & 255);
    if (i < (NE - CV_E0) * 512) return (CV_E0 + (i >> 9)) * 768 + (i & 511);
    i -= (NE - CV_E0) * 512; return (CV_E1 + (i >> 8)) * 768 + 512 + (i & 255);
}
struct NoPre { __device__ __forceinline__ void operator()() const {} };
template <class Pre = NoPre> __device__ __forceinline__ void p5_expert_weights(const Args& args, LAS unsigned char* lds, int pool, int gw, int NGW, int NPAIRS, int wave, int lane, Pre pre = Pre()) {
    LAS float* scr = (LAS float*)(lds + wave * 16384); LAS unsigned char* img = lds + wave * 16384 + 8448;
    const int mine = (gw < NPAIRS) ? (NPAIRS - gw + NGW - 1) / NGW : 0;
    const int ncpl = mine / 2;
    f32x4 va[8], vb[8], vc[8], vd[8];
    TrSrc ta, tb, tc, td;
    int it = gw;
    if (ncpl > 0) {
        ta = expert_half(args, pool_pair(pool, it), 0); tr_load(ta, va, lane); tb = expert_half(args, pool_pair(pool, it), 1); tr_load(tb, vb, lane);
        tc = expert_half(args, pool_pair(pool, it + NGW), 0); tr_load(tc, vc, lane); td = expert_half(args, pool_pair(pool, it + NGW), 1); tr_load(td, vd, lane);
    }
    pre();
    if (ncpl > 0) {
#pragma unroll 1
        for (int q = 0; q + 1 < ncpl; ++q) {
            it += 2 * NGW;
            { const TrSrc f = ta; tr_stage_f8(ta, va, scr, img, 0, lane); ta = expert_half(args, pool_pair(pool, it), 0); tr_load(ta, va, lane);
              tr_stage_f8(tb, vb, scr, img, 1, lane); tb = expert_half(args, pool_pair(pool, it), 1); tr_load(tb, vb, lane); pair_flush(f, img, lane); }
            { const TrSrc f = tc; tr_stage_f8(tc, vc, scr, img, 0, lane); tc = expert_half(args, pool_pair(pool, it + NGW), 0); tr_load(tc, vc, lane);
              tr_stage_f8(td, vd, scr, img, 1, lane); td = expert_half(args, pool_pair(pool, it + NGW), 1); tr_load(td, vd, lane); pair_flush(f, img, lane); }
        }
        tr_stage_f8(ta, va, scr, img, 0, lane); tr_stage_f8(tb, vb, scr, img, 1, lane); pair_flush(ta, img, lane);
        tr_stage_f8(tc, vc, scr, img, 0, lane); tr_stage_f8(td, vd, scr, img, 1, lane); pair_flush(tc, img, lane);
        it += 2 * NGW;
    }
    if (mine & 1) {
        ta = expert_half(args, pool_pair(pool, it), 0); tr_load(ta, va, lane); tb = expert_half(args, pool_pair(pool, it), 1); tr_load(tb, vb, lane);
        tr_stage_f8(ta, va, scr, img, 0, lane); tr_stage_f8(tb, vb, scr, img, 1, lane); pair_flush(ta, img, lane);
    }
}

template <class Pre = NoPre> __device__ __forceinline__ void conv_phase(const Args& args, LAS unsigned char* lds, int vcu, int G, int tid, int wave, int lane, Pre pre = Pre()) {
    unsigned char* ws = args.ws;
    const unsigned* U32 = (const unsigned*)(ws + WS_U); bf16_t* C = (bf16_t*)(ws + WS_R2);
    const float* cw = args.in[I_CONVW]; const float* cb = args.in[I_CONVB]; const float* lng = args.in[I_LNG]; const float* lnb = args.in[I_LNB];
    LAS float* T = (LAS float*)lds;
    f32x2 w[KCONV];
#pragma unroll
    for (int j = 0; j < KCONV; ++j) w[j] = *(const f32x2*)(cw + j * D + 2 * tid);
    const f32x2 cbv = *(const f32x2*)(cb + 2 * tid);
    LAS f32x4* lgb = (LAS f32x4*)(lds + MISC_OFF + MISC_IDX);
    if (tid < 256) { lgb[tid] = ((const f32x4*)lng)[tid]; lgb[256 + tid] = ((const f32x4*)lnb)[tid]; }
    pre();
    unsigned raw[62];
#define CONV_LOAD(unx) do { const int b_ = (unx) / (SEQ / 32), t0_ = ((unx) % (SEQ / 32)) * 32; const size_t rb_ = (size_t)b_ * SEQ; \
        _Pragma("unroll") for (int s = 0; s < 62; ++s) { const int ts = t0_ - 30 + s; const unsigned v_ = U32[(rb_ + (size_t)(ts < 0 ? 0 : ts)) * (D / 2) + tid]; raw[s] = (ts >= 0) ? v_ : 0u; } } while (0)
    if (vcu < BATCH * (SEQ / 32)) CONV_LOAD(vcu);
    for (int un = vcu; un < BATCH * (SEQ / 32); un += G) {
        const int b = un / (SEQ / 32), t0 = (un % (SEQ / 32)) * 32;
        const size_t rowbase = (size_t)b * SEQ;
        f32x2 in[62];
#pragma unroll
        for (int s = 0; s < 62; ++s) in[s] = (f32x2){bf_lo(raw[s]), bf_hi(raw[s])};
#define CONV_O(o) { f32x2 a_ = cbv; _Pragma("unroll") for (int j = 0; j < KCONV; ++j) a_ = w[j] * in[(o) + j] + a_; *(LAS f32x2*)(T + (o) * D + 2 * tid) = a_; }
        CONV_O(0) CONV_O(1) CONV_O(2) CONV_O(3) CONV_O(4) CONV_O(5) CONV_O(6) CONV_O(7) CONV_O(8) CONV_O(9) CONV_O(10) CONV_O(11) CONV_O(12) CONV_O(13) CONV_O(14) CONV_O(15)
        CONV_O(16) CONV_O(17) CONV_O(18) CONV_O(19) CONV_O(20) CONV_O(21) CONV_O(22) CONV_O(23) CONV_O(24) CONV_O(25) CONV_O(26) CONV_O(27) CONV_O(28) CONV_O(29) CONV_O(30) CONV_O(31)
#undef CONV_O
        if (un + G < BATCH * (SEQ / 32)) CONV_LOAD(un + G);
        LDS_WAIT(); __builtin_amdgcn_s_barrier(); asm volatile("" ::: "memory");
#pragma unroll 2
        for (int i = 0; i < 4; ++i) {
            const int o = 4 * wave + i;
            f32x4 v[4]; float s = 0.f;
#pragma unroll
            for (int c = 0; c < 4; ++c) { v[c] = *(const LAS f32x4*)(T + o * D + 256 * c + 4 * lane); s += (v[c][0] + v[c][1]) + (v[c][2] + v[c][3]); }
            const float mean = wave_sum(s) * (1.f / D); float q = 0.f;
#pragma unroll
            for (int c = 0; c < 4; ++c) { v[c] = v[c] - mean; q += (v[c][0] * v[c][0] + v[c][1] * v[c][1]) + (v[c][2] * v[c][2] + v[c][3] * v[c][3]); }
            const float rstd = 1.0f / sqrtf(wave_sum(q) * (1.f / D) + EPS);
            u32x2* op = (u32x2*)(C + (rowbase + t0 + o) * D) + lane;
#pragma unroll
            for (int c = 0; c < 4; ++c) {
                f32x4 y = v[c] * rstd * lgb[64 * c + lane] + lgb[256 + 64 * c + lane];
#pragma unroll
                for (int j = 0; j < 4; ++j) y[j] = y[j] * sigmoid_f(y[j]);
                u32x2 pk; pk.x = cvt_pk_bf16(y[0], y[1]); pk.y = cvt_pk_bf16(y[2], y[3]); op[64 * c] = pk;
            }
        }
        LDS_WAIT(); __builtin_amdgcn_s_barrier(); asm volatile("" ::: "memory");
    }
}

#undef CONV_LOAD
constexpr int AT_K = 0, AT_V = 32768, AT_OST = 65536;
__device__ __forceinline__ int crow(int r, int hi) { return (r & 3) + 8 * (r >> 2) + 4 * hi; }
__device__ __forceinline__ s16x4 vtr(const LAS unsigned char* p) { typedef short v4i16_t __attribute__((ext_vector_type(4))); return __builtin_bit_cast(s16x4, __builtin_amdgcn_ds_read_tr16_b64_v4i16((LAS v4i16_t*)p)); }
__device__ __forceinline__ void attn_phase(const Args& args, LAS unsigned char* lds, int vcu, int G, int wave, int lane) {
    unsigned char* ws = args.ws;
    const bf16_t* KV = (const bf16_t*)(ws + WS_KV); bf16_t* QO = (bf16_t*)(ws + WS_QO);
    const int r32 = lane & 31, hi = lane >> 5;
    const LAS unsigned char* kbase = lds + AT_K + hi * 1024 + r32 * 16;
    const LAS unsigned char* vbase = lds + AT_V + ((lane >> 4) & 1) * 32 + (lane & 3) * 8 + (4 * hi + ((lane & 15) >> 2)) * 64;
    LAS bf16_t* stg = (LAS bf16_t*)(lds + AT_OST + wave * 4096);
    const int dq = r32 - 4 * hi;
    for (int un = vcu; un < BATCH * 2 * (SEQ / 128); un += G) {
        const int qb = un % (SEQ / 128), kvh = (un / (SEQ / 128)) & 1, b = un / (2 * (SEQ / 128));
        const int h = kvh * 8 + wave;
        const long T0 = (long)b * SEQ + 128 * qb;
#pragma unroll
        for (int t = 0; t < 4; ++t) {
            if (qb > 0 || t >= 2) {
                const long tok0 = T0 - 128 + 64 * t;
                const bf16_t* ks = KV + (size_t)(tok0 + lane) * 256 + kvh * 64 + wave * 8;
                const bf16_t* vs = KV + (size_t)(tok0 + 16 * (wave & 3) + (lane >> 2)) * 256 + 128 + kvh * 64 + (wave >> 2) * 32 + (lane & 3) * 8;
                __builtin_amdgcn_global_load_lds((const unsigned*)ks, (LAS unsigned*)(lds + AT_K + t * 8192 + wave * 1024), 16, 0, 0);
                __builtin_amdgcn_global_load_lds((const unsigned*)vs, (LAS unsigned*)(lds + AT_V + t * 8192 + wave * 1024), 16, 0, 0);
            }
        }
        const float slope2 = fast_exp2(-0.5f * (float)(h + 1)) * LOG2E;
        const float sink2 = args.in[I_SINKS][h] * LOG2E;
        f32x16 bias0;
#pragma unroll
        for (int r = 0; r < 16; ++r) bias0[r] = -slope2 * (float)(r32 - crow(r, hi));
        float drel[5];
#pragma unroll
        for (int rel = 0; rel < 5; ++rel) drel[rel] = fast_exp2(-32.f * (float)(4 - rel) * slope2);
        asm volatile("s_waitcnt vmcnt(0)" ::: "memory"); __builtin_amdgcn_s_barrier(); asm volatile("" ::: "memory");
#pragma unroll 1
        for (int qs = 0; qs < 4; ++qs) {
            const bf16_t* Qw = QO + (size_t)(T0 + 32 * qs + r32) * D + h * 64 + hi * 8;
            bf16x8 qr[4];
#pragma unroll
            for (int d0 = 0; d0 < 4; ++d0) qr[d0] = __builtin_nontemporal_load((const bf16x8*)(Qw + d0 * 16));
            f32x16 S[5];
#pragma unroll
            for (int rel = 0; rel < 5; ++rel) {
                const int blk = qs + rel;
                const bool valid = (qb > 0) || (blk >= 4);
                if (valid) {
                    S[rel] = bias0;
                    const LAS unsigned char* kp = kbase + (blk >> 1) * 8192 + (blk & 1) * 512;
#pragma unroll
                    for (int d0 = 0; d0 < 4; ++d0) { const bf16x8 kf = *(const LAS bf16x8*)(kp + d0 * 2048); S[rel] = __builtin_amdgcn_mfma_f32_32x32x16_bf16(kf, qr[d0], S[rel], 0, 0, 0); }
                } else {
#pragma unroll
                    for (int r = 0; r < 16; ++r) S[rel][r] = -INFINITY;
                }
            }
#pragma unroll
            for (int r = 0; r < 16; ++r) { const int rc = (r & 3) + 8 * (r >> 2); if (!(rc > dq)) S[0][r] = -INFINITY; if (!(rc <= dq)) S[4][r] = -INFINITY; }
            float l = 0.f;
#pragma unroll
            for (int rel = 0; rel < 5; ++rel) { float ls = 0.f;
#pragma unroll
                for (int r = 0; r < 16; ++r) { const float p = fast_exp2(S[rel][r]); S[rel][r] = p; ls += p; }
                l += ls * drel[rel]; }
            l += __shfl_xor(l, 32);
            l += fast_exp2(sink2);
            const float inv0 = 1.0f / l;
            f32x16 o[2];
#pragma unroll
            for (int r = 0; r < 16; ++r) { o[0][r] = 0.f; o[1][r] = 0.f; }
#pragma unroll
            for (int rel = 0; rel < 5; ++rel) {
                const int blk = qs + rel;
                const bool valid = (qb > 0) || (blk >= 4);
                if (valid) {
                    const LAS unsigned char* vp = vbase + (blk >> 1) * 8192 + (blk & 1) * 2048;
                    const float inv = inv0 * drel[rel];
#pragma unroll
                    for (int s = 0; s < 2; ++s) {
                        u32x4 pw;
                        pw.x = cvt_pk_bf16(S[rel][8 * s + 0] * inv, S[rel][8 * s + 1] * inv); pw.y = cvt_pk_bf16(S[rel][8 * s + 2] * inv, S[rel][8 * s + 3] * inv);
                        pw.z = cvt_pk_bf16(S[rel][8 * s + 4] * inv, S[rel][8 * s + 5] * inv); pw.w = cvt_pk_bf16(S[rel][8 * s + 6] * inv, S[rel][8 * s + 7] * inv);
                        const bf16x8 pa = __builtin_bit_cast(bf16x8, pw);
#pragma unroll
                        for (int d0 = 0; d0 < 2; ++d0) {
                            const s16x4 lo = vtr(vp + d0 * 4096 + s * 1024), hh = vtr(vp + d0 * 4096 + s * 1024 + 512);
                            const bf16x8 vf = (bf16x8){lo[0], lo[1], lo[2], lo[3], hh[0], hh[1], hh[2], hh[3]};
                            o[d0] = __builtin_amdgcn_mfma_f32_32x32x16_bf16(pa, vf, o[d0], 0, 0, 0);
                        }
                    }
                }
            }
#pragma unroll
            for (int r = 0; r < 16; ++r) { const int orow = crow(r, hi);
#pragma unroll
                for (int d0 = 0; d0 < 2; ++d0) stg[orow * 64 + d0 * 32 + r32] = (bf16_t)(cvt_pk_bf16(o[d0][r], 0.f) & 0xffffu); }
            LDS_WAIT(); asm volatile("" ::: "memory");
            bf16_t* Ow = QO + (size_t)(T0 + 32 * qs) * D + h * 64;
#pragma unroll
            for (int i = 0; i < 4; ++i) { const int row = i * 8 + (lane >> 3), ch = lane & 7; const u32x4 v = *(const LAS u32x4*)(stg + row * 64 + ch * 8); *(u32x4*)(Ow + (size_t)row * D + ch * 8) = v; }
            LDS_WAIT(); asm volatile("" ::: "memory");
        }
        LDS_WAIT(); __builtin_amdgcn_s_barrier(); asm volatile("" ::: "memory");
    }
}

__device__ __forceinline__ unsigned okey(float v, int idx) { unsigned u = __float_as_uint(v); u = (u & 0x80000000u) ? ~u : (u | 0x80000000u); return (u & ~31u) | (unsigned)(31 - idx); }
__device__ __forceinline__ float okey_val(unsigned k) { unsigned u = k & ~31u; u = (u & 0x80000000u) ? (u & 0x7fffffffu) : ~u; return __uint_as_float(u); }
__device__ __forceinline__ void router_preload(const Args& args, LAS unsigned char* lds, int tid) {
    constexpr int WROW = 2064;
    const u32x4* src = (const u32x4*)(args.ws + WS_WRT);
    for (int idx = tid; idx < NE * D * 2 / 16; idx += 512) { const int e = idx >> 7, c = idx & 127; *(LAS u32x4*)(lds + e * WROW + c * 16) = src[idx]; }
    for (int idx = tid; idx < D / 4; idx += 512) ((LAS f32x4*)(lds + MISC_OFF + MISC_IDX))[idx] = ((const f32x4*)args.in[I_GFFN])[idx];
}
__device__ __forceinline__ void router_phase(const Args& args, LAS unsigned char* lds, int vcu, int G, int tid, int wave, int lane) {
    unsigned char* ws = args.ws;
    const bf16_t* X1B = (const bf16_t*)(ws + WS_R2); unsigned char* X1F8 = ws + WS_X1F8;
    float* tokw = (float*)(ws + WS_TOKW); int* list = (int*)(ws + WS_LIST);
    gu32* gcnt = (gu32*)(ws + WS_CTL) + CW_GCNT;
    constexpr int WROW = 2064;
    LAS int* hist = (LAS int*)(lds + MISC_OFF + MISC_HIST); LAS int* sbase = (LAS int*)(lds + MISC_OFF + MISC_SBASE);
    LAS int* etab = (LAS int*)(lds + MISC_OFF + MISC_ETAB); LAS int* ltab = (LAS int*)(lds + MISC_OFF + MISC_LTAB);
    if (N_LAUNCHES != 1) router_preload(args, lds, tid);
    const int ce = lane & 15, kg = lane >> 4;
    const float br0 = args.in[I_BR][ce], br1 = args.in[I_BR][16 + ce];
    for (int grp = vcu; grp < M / 128; grp += G) {
        if (tid < NE) hist[tid] = 0;
        LDS_WAIT(); __builtin_amdgcn_s_barrier(); asm volatile("" ::: "memory");
        const int tokb = grp * 128 + wave * 16, tokA = tokb + ce;
        f32x4 acc0 = (f32x4){0.f, 0.f, 0.f, 0.f}, acc1 = (f32x4){0.f, 0.f, 0.f, 0.f}; float ss = 0.f;
        const LAS unsigned char* wp = lds + ce * WROW + kg * 16;
        const bf16_t* xrow = X1B + (size_t)tokA * D + 8 * kg;
#pragma unroll 1
        for (int c = 0; c < 4; ++c) {
            u32x4 a[8];
#pragma unroll
            for (int i = 0; i < 8; ++i) a[i] = *(const u32x4*)(xrow + 32 * (8 * c + i));
#pragma unroll
            for (int i = 0; i < 8; ++i) {
                const int ks = 8 * c + i;
                const bf16x8 b0 = *(const LAS bf16x8*)(wp + ks * 64), b1 = *(const LAS bf16x8*)(wp + 16 * WROW + ks * 64);
                const bf16x8 av = __builtin_bit_cast(bf16x8, a[i]);
                acc0 = __builtin_amdgcn_mfma_f32_16x16x32_bf16(av, b0, acc0, 0, 0, 0);
                acc1 = __builtin_amdgcn_mfma_f32_16x16x32_bf16(av, b1, acc1, 0, 0, 0);
#pragma unroll
                for (int q = 0; q < 4; ++q) { const float lo = bf_lo(a[i][q]), hi = bf_hi(a[i][q]); ss += lo * lo + hi * hi; }
            }
        }
        ss += __shfl_xor(ss, 16); ss += __shfl_xor(ss, 32);
        const float rs = 1.0f / sqrtf(ss * (1.f / D) + EPS);
#pragma unroll 1
        for (int c = 0; c < 4; ++c) {
            u32x4 a[8];
#pragma unroll
            for (int i = 0; i < 8; ++i) a[i] = __builtin_nontemporal_load((const u32x4*)(xrow + 32 * (8 * c + i)));
#pragma unroll
            for (int i = 0; i < 8; ++i) {
                u32x2 pk;
                const LAS f32x4* gl = (const LAS f32x4*)(lds + MISC_OFF + MISC_IDX) + (32 * (8 * c + i) + 8 * kg) / 4;
                const f32x4 g0 = gl[0] * rs, g1 = gl[1] * rs;
                pk.x = pack4_fp8(bf_lo(a[i][0]) * g0[0], bf_hi(a[i][0]) * g0[1], bf_lo(a[i][1]) * g0[2], bf_hi(a[i][1]) * g0[3]);
                pk.y = pack4_fp8(bf_lo(a[i][2]) * g1[0], bf_hi(a[i][2]) * g1[1], bf_lo(a[i][3]) * g1[2], bf_hi(a[i][3]) * g1[3]);
                *(u32x2*)(X1F8 + (size_t)tokA * D + 32 * (8 * c + i) + 8 * kg) = pk;
            }
        }
#pragma unroll
        for (int r = 0; r < 4; ++r) {
            const float rsr = __shfl(rs, 4 * kg + r);
            unsigned k0 = okey(acc0[r] * rsr + br0, ce), k1 = okey(acc1[r] * rsr + br1, 16 + ce);
            float tv[4]; int te[4];
#pragma unroll
            for (int k = 0; k < 4; ++k) {
                unsigned m = k0 > k1 ? k0 : k1;
#pragma unroll
                for (int o = 1; o < 16; o <<= 1) { const unsigned t = (unsigned)__shfl_xor((int)m, o); m = t > m ? t : m; }
                const int sel = 31 - (int)(m & 31u); te[k] = sel; tv[k] = okey_val(m);
                if (sel == ce) k0 = 0u; if (sel == 16 + ce) k1 = 0u;
            }
            const float e1 = __expf(tv[1] - tv[0]), e2 = __expf(tv[2] - tv[0]), e3 = __expf(tv[3] - tv[0]);
            const float inv = 1.0f / (1.0f + e1 + e2 + e3);
            if (ce < 4) {
                const int ek = ce == 0 ? te[0] : ce == 1 ? te[1] : ce == 2 ? te[2] : te[3];
                const float wk = (ce == 0 ? 1.0f : ce == 1 ? e1 : ce == 2 ? e2 : e3) * inv;
                const int tli = wave * 16 + 4 * kg + r;
                const int lp = __hip_atomic_fetch_add(hist + ek, 1, __ATOMIC_RELAXED, __HIP_MEMORY_SCOPE_WORKGROUP);
                etab[tli * 4 + ce] = ek; ltab[tli * 4 + ce] = lp;
                tokw[(size_t)(tokb + 4 * kg + r) * 4 + ce] = wk;
            }
        }
        LDS_WAIT(); __builtin_amdgcn_s_barrier(); asm volatile("" ::: "memory");
        if (tid < NE) sbase[tid] = (int)__hip_atomic_fetch_add(gcnt + tid, (unsigned)hist[tid], RLX_AGENT);
        LDS_WAIT(); __builtin_amdgcn_s_barrier(); asm volatile("" ::: "memory");
        { const int e = etab[tid], pos = sbase[e] + ltab[tid]; list[(size_t)e * LIST_CAP + pos] = ((grp * 128 + (tid >> 2)) << 2) | (tid & 3);
          ((int*)(ws + WS_ROWOF))[grp * 512 + tid] = (e << 16) | pos; }
        LDS_WAIT(); __builtin_amdgcn_s_barrier(); asm volatile("" ::: "memory");
    }
}

__device__ __forceinline__ void build_moe_table(const Args& args, LAS unsigned char* lds, int tid) {
    LAS int* tbl = (LAS int*)(lds + MISC_OFF + MISC_TBL);
    gu32* gcnt = (gu32*)(args.ws + WS_CTL) + CW_GCNT;
    if (tid < 64) {
        const int c = (tid < NE) ? (int)__hip_atomic_load(gcnt + (tid & 31), RLX_AGENT) : 0; const int nrt = (c + 255) >> 8; int inc = nrt;
#pragma unroll
        for (int o = 1; o < 32; o <<= 1) { const int t = __shfl_up(inc, o); if ((tid & 63) >= o) inc += t; }
        if (tid < NE) tbl[tid] = inc - nrt; if (tid == NE - 1) tbl[NE] = inc;
        int ci = c;
#pragma unroll
        for (int o = 1; o < 32; o <<= 1) { const int t = __shfl_up(ci, o); if ((tid & 63) >= o) ci += t; }
        if (tid < NE) ((LAS int*)(lds + MISC_OFF + MISC_CPRE))[tid] = ci - c; if (tid == NE - 1) ((LAS int*)(lds + MISC_OFF + MISC_CPRE))[NE] = ci;
    }
    LDS_WAIT(); __syncthreads();
}

template <class Pre> __device__ __forceinline__ void final_phase(const Args& args, LAS unsigned char* lds, int vcu, int G, int wave, int lane, Pre pre) {
    unsigned char* ws = args.ws;
    const bf16_t* X1B = (const bf16_t*)(ws + WS_R2); const float* tokw = (const float*)(ws + WS_TOKW); const float* gfin = args.in[I_GFIN];
    const unsigned char* Y = ws + WS_Y; const int* rowof = (const int*)(ws + WS_ROWOF);
    const int gw = vcu * 8 + wave, NGW = G * 8;
    f32x4 gv[4];
#pragma unroll
    for (int q = 0; q < 4; ++q) gv[q] = *(const f32x4*)(gfin + 16 * lane + 4 * q);
    int cp;
    { const int c = (lane < NE) ? (int)__hip_atomic_load((gu32*)(ws + WS_CTL) + CW_GCNT + (lane & 31), RLX_AGENT) : 0; int inc = c;
#pragma unroll
      for (int o = 1; o < 32; o <<= 1) { const int t = __shfl_up(inc, o); if (lane >= o) inc += t; }
      cp = inc - c; }
    int4 rw[2];
#pragma unroll
    for (int t = 0; t < 2; ++t) { const int tok = gw + t * NGW; rw[t] = (tok < M) ? *(const int4*)(rowof + (size_t)tok * 4) : make_int4(0, 0, 0, 0); }
    pre();
    for (int tok0 = gw; tok0 < M; tok0 += 2 * NGW) {
        f32x4 w[2]; u32x4 xa[2], xb[2], y[2][4];
#pragma unroll
        for (int t = 0; t < 2; ++t) { const int tok = tok0 + t * NGW; if (tok < M) {
            const int iw[4] = {__builtin_amdgcn_readfirstlane(rw[t].x), __builtin_amdgcn_readfirstlane(rw[t].y), __builtin_amdgcn_readfirstlane(rw[t].z), __builtin_amdgcn_readfirstlane(rw[t].w)};
            int rk[4];
#pragma unroll
            for (int k = 0; k < 4; ++k) rk[k] = __builtin_amdgcn_readlane(cp, iw[k] >> 16) + (iw[k] & 0xffff);
            w[t] = *(const f32x4*)(tokw + (size_t)tok * 4);
            xa[t] = __builtin_nontemporal_load((const u32x4*)(X1B + (size_t)tok * D + 16 * lane)); xb[t] = __builtin_nontemporal_load((const u32x4*)(X1B + (size_t)tok * D + 16 * lane + 8));
#pragma unroll
            for (int k = 0; k < 4; ++k) y[t][k] = __builtin_nontemporal_load((const u32x4*)(Y + (size_t)rk[k] * 1024 + 16 * lane)); } }
#pragma unroll
        for (int t = 0; t < 2; ++t) { const int tok = tok0 + 2 * NGW + t * NGW; rw[t] = (tok < M) ? *(const int4*)(rowof + (size_t)tok * 4) : make_int4(0, 0, 0, 0); }
#pragma unroll
        for (int t = 0; t < 2; ++t) { const int tok = tok0 + t * NGW; if (tok < M) {
            f32x4 v[4];
            v[0] = (f32x4){bf_lo(xa[t].x), bf_hi(xa[t].x), bf_lo(xa[t].y), bf_hi(xa[t].y)}; v[1] = (f32x4){bf_lo(xa[t].z), bf_hi(xa[t].z), bf_lo(xa[t].w), bf_hi(xa[t].w)};
            v[2] = (f32x4){bf_lo(xb[t].x), bf_hi(xb[t].x), bf_lo(xb[t].y), bf_hi(xb[t].y)}; v[3] = (f32x4){bf_lo(xb[t].z), bf_hi(xb[t].z), bf_lo(xb[t].w), bf_hi(xb[t].w)};
            float s = 0.f;
#pragma unroll
            for (int q = 0; q < 4; ++q) {
#pragma unroll
                for (int k = 0; k < 4; ++k) {
                    const int word = (int)y[t][k][q];
                    const f32x2 lo = __builtin_amdgcn_cvt_pk_f32_fp8(word, false), hi = __builtin_amdgcn_cvt_pk_f32_fp8(word, true);
                    v[q] += w[t][k] * (f32x4){lo[0], lo[1], hi[0], hi[1]};
                }
                s += (v[q][0] * v[q][0] + v[q][1] * v[q][1]) + (v[q][2] * v[q][2] + v[q][3] * v[q][3]);
            }
            const float rstd = 1.0f / sqrtf(wave_sum(s) * (1.f / D) + EPS);
            asm volatile("" ::: "memory");
#pragma unroll
            for (int q = 0; q < 4; ++q) v[q] = v[q] * rstd * gv[q];
            LAS unsigned char* sc = lds + wave * 8192 + t * 4096;
#pragma unroll
            for (int q = 0; q < 4; ++q) *(LAS f32x4*)(sc + 64 * lane + 16 * ((q + lane) & 3)) = v[q];
            asm volatile("s_waitcnt lgkmcnt(0)" ::: "memory");
#pragma unroll
            for (int q = 0; q < 4; ++q) { const int ls = (lane >> 2) + 16 * q, qs = lane & 3;
                const f32x4 o = *(const LAS f32x4*)(sc + 64 * ls + 16 * ((qs + ls) & 3));
                __builtin_nontemporal_store(o, (f32x4*)(args.out + (size_t)tok * D + 256 * q + 4 * lane)); }
            asm volatile("" ::: "memory"); } }
    }
}

__global__ void __launch_bounds__(512, 2) mk_fwd(Args args) {
    extern __shared__ __attribute__((aligned(16))) unsigned char lds_raw[];
    LAS unsigned char* lds = (LAS unsigned char*)lds_raw;
    const int tid = threadIdx.x, lane = tid & 63, wave = __builtin_amdgcn_readfirstlane(tid >> 6);
    const int G = gridDim.x; const int bx = blockIdx.x; const int vcu = (G % 8 == 0) ? (bx % 8) * (G / 8) + bx / 8 : bx;
    unsigned char* ws = args.ws;
    gu32* ctl = (gu32*)(ws + WS_CTL);
    if (tid < 4) ((LAS unsigned*)(lds + MISC_OFF + MISC_XB))[tid] = 0u;
    __syncthreads();
    XcdBarrier bar; bar.bar = (unsigned*)ctl + CW_BAR; bar.x = 0; bar.st = nullptr;
    if (N_LAUNCHES == 1) bar = xcd_barrier_post((unsigned*)ctl + CW_BAR, (volatile LAS unsigned*)(lds + MISC_OFF + MISC_XB));
    const int lo = args.ph_lo, hi = args.ph_hi;
#ifndef ONLY_PHASE
#define ONLY_PHASE -1
#endif
#define IN(k) ((ONLY_PHASE < 0 || (k) == ONLY_PHASE) && lo <= (k) && (k) < hi)
#define BOTH(k) (IN(k) && IN((k) + 1))
#ifndef REP_BAR
#define REP_BAR 1
#endif
#define GRID_BAR() do { xcd_barrier(bar); if (REP_BAR >= 2) { xcd_barrier(bar); xcd_barrier(bar); } } while (0)

    if (IN(0)) { for (int rep = 0; rep < REP_P0; ++rep) { p0_prologue(args, lds, vcu, G, wave, lane); __syncthreads(); } if (BOTH(0)) GRID_BAR(); }

    if (IN(1)) {
        mg::DenseSched<1024> S; S.so.init(M, NIN, G, bx); S.A = (const char*)(ws + WS_R2); S.Bt = (const char*)(ws + WS_WIN);
        mg::EpiIn E{(const float*)(ws + WS_BPERM), (bf16_t*)(ws + WS_U), (bf16_t*)(ws + WS_QO), (bf16_t*)(ws + WS_KV), (bf16_t*)(ws + WS_RR), (bf16_t*)(ws + WS_GA), 0};
        if (bx >= G / 2) { p5_expert_weights(args, lds, 0, (bx - G / 2) * 8 + wave, (G / 2) * 8, CV_POOL0, wave, lane); }
        __syncthreads();
        mg::gemm_phase<mg::EpiIn, mg::DenseSched<1024>>(lds, S, E);
        if (REP_P1 >= 2 && REP_NULL == 2) { mg::EpiInT<false> E2{E.bperm, E.U, E.Q, E.KV, E.RR, E.GA, args.li}; mg::gemm_phase<mg::EpiInT<false>, mg::DenseSched<1024>>(lds, S, E2); }
        else if (REP_P1 >= 2) { if (REP_NULL == 1) { mg::EpiNull<mg::EpiIn> EN{E}; mg::gemm_phase<mg::EpiNull<mg::EpiIn>, mg::DenseSched<1024>>(lds, S, EN); } else mg::gemm_phase<mg::EpiIn, mg::DenseSched<1024>>(lds, S, E); }
        if (BOTH(1) && N_LAUNCHES != 1) GRID_BAR();
    }

    if (IN(2)) {
        const bool conv_first = ((bx >> 3) & 1) != 0;
        auto bar12 = [&]() { if (N_LAUNCHES == 1) GRID_BAR(); };
        if (!conv_first) { p5_expert_weights(args, lds, 2, vcu * 8 + wave, G * 8, CV_POOL2, wave, lane, bar12); __syncthreads(); conv_phase(args, lds, vcu, G, tid, wave, lane); }
        else conv_phase(args, lds, vcu, G, tid, wave, lane, bar12);
        if (REP_CONV >= 2) { int t_ = threadIdx.x; asm volatile("" : "+v"(t_)); __syncthreads(); conv_phase(args, lds, vcu, G, t_, __builtin_amdgcn_readfirstlane(t_ >> 6), t_ & 63); }
        attn_phase(args, lds, vcu, G, wave, lane);
        if (conv_first) { __syncthreads(); p5_expert_weights(args, lds, 2, vcu * 8 + wave, G * 8, CV_POOL2, wave, lane); }
        if (BOTH(2)) GRID_BAR();
    }

    if (IN(3)) {
        mg::MixSched S; S.so.init(M, D, G, bx); S.A0 = (const char*)(ws + WS_R2); S.A1 = (const char*)(ws + WS_QO); S.B0 = (const char*)(ws + WS_WCO); S.B1 = (const char*)(ws + WS_WAO);
        mg::EpiMix E{(const bf16_t*)(ws + WS_RR), (const bf16_t*)(ws + WS_GA), args.in[I_BCO], args.in[I_BAO], (bf16_t*)(ws + WS_MIX)};
        mg::gemm_phase<mg::EpiMix, mg::MixSched>(lds, S, E);
        if (REP_P3 >= 2) { if (REP_NULL == 1) { mg::EpiNull<mg::EpiMix> EN{E}; mg::gemm_phase<mg::EpiNull<mg::EpiMix>, mg::MixSched>(lds, S, EN); } else mg::gemm_phase<mg::EpiMix, mg::MixSched>(lds, S, E); }
        if (BOTH(3)) GRID_BAR();
    }

    if (IN(4)) {
        mg::DenseSched<2048> S; S.so.init(M, D, G, bx); S.A = (const char*)(ws + WS_MIX); S.Bt = (const char*)(ws + WS_WO);
        mg::EpiRes E{args.in[I_X], (bf16_t*)(ws + WS_R2)};
        mg::gemm_phase<mg::EpiRes, mg::DenseSched<2048>>(lds, S, E);
        if (REP_P4 >= 2) { if (REP_NULL == 1) { mg::EpiNull<mg::EpiRes> EN{E}; mg::gemm_phase<mg::EpiNull<mg::EpiRes>, mg::DenseSched<2048>>(lds, S, EN); } else mg::gemm_phase<mg::EpiRes, mg::DenseSched<2048>>(lds, S, E); }
        if (N_LAUNCHES == 1) { int t_ = threadIdx.x; asm volatile("" : "+v"(t_)); router_preload(args, lds, t_); }
        if (BOTH(4)) GRID_BAR();
    }

    if (IN(5)) {
        router_phase(args, lds, vcu, G, tid, wave, lane);
        if (BOTH(5)) GRID_BAR();
    }

    if (IN(6)) {
        build_moe_table(args, lds, tid);
        {
            const int rem = (((const LAS int*)(lds + MISC_OFF + MISC_TBL))[NE] * 8) % G, ns = G - rem;
            if (rem > 0 && ns >= G / 4) { if (vcu >= rem) p5_expert_weights(args, lds, 1, (vcu - rem) * 8 + wave, ns * 8, CV_POOL1, wave, lane); }
            else p5_expert_weights(args, lds, 1, vcu * 8 + wave, G * 8, CV_POOL1, wave, lane);
            __syncthreads();
        }
        mg::MoeSched<8, true, 1024> S{(const LAS int*)(lds + MISC_OFF + MISC_TBL), vcu, G, (const char*)(ws + WS_X1F8), (const char*)(ws + WS_WGU), (const int*)(ws + WS_LIST)};
        S.preload(lds, tid);
        mg::EpiSwiglu E{args.in[I_BG], args.in[I_BU], ws + WS_ACT};
        mg::gemm_phase<mg::EpiSwiglu, mg::MoeSched<8, true, 1024>>(lds, S, E);
        if (REP_P6 >= 2) { if (REP_NULL == 1) { mg::EpiNull<mg::EpiSwiglu> EN{E}; mg::gemm_phase<mg::EpiNull<mg::EpiSwiglu>, mg::MoeSched<8, true, 1024>>(lds, S, EN); } else mg::gemm_phase<mg::EpiSwiglu, mg::MoeSched<8, true, 1024>>(lds, S, E); }
        if (BOTH(6)) GRID_BAR();
    }

    if (IN(7)) {
        if (N_LAUNCHES != 1) build_moe_table(args, lds, tid);
        mg::MoeSched<4, false, 1024> S{(const LAS int*)(lds + MISC_OFF + MISC_TBL), vcu, G, (const char*)(ws + WS_ACT), (const char*)(ws + WS_WD), (const int*)(ws + WS_LIST)};
        S.preload(lds, tid);
        mg::EpiDown E{(const LAS int*)(lds + MISC_OFF), args.in[I_BD], ws + WS_Y};
        mg::gemm_phase<mg::EpiDown, mg::MoeSched<4, false, 1024>>(lds, S, E);
        if (REP_P7 >= 2) { if (REP_NULL == 1) { mg::EpiNull<mg::EpiDown> EN{E}; mg::gemm_phase<mg::EpiNull<mg::EpiDown>, mg::MoeSched<4, false, 1024>>(lds, S, EN); } else mg::gemm_phase<mg::EpiDown, mg::MoeSched<4, false, 1024>>(lds, S, E); }
        if (BOTH(7) && N_LAUNCHES != 1) GRID_BAR();
    }

    if (IN(8)) { int t_ = threadIdx.x; asm volatile("" : "+v"(t_)); const int lane8 = t_ & 63, wave8 = __builtin_amdgcn_readfirstlane(t_ >> 6);
        final_phase(args, lds, vcu, G, wave8, lane8, [&]() { if (N_LAUNCHES == 1) GRID_BAR(); });
        if (REP_P8 >= 2) { __syncthreads(); final_phase(args, lds, vcu, G, wave8, lane8, []() {}); } }
#undef IN
#undef BOTH
#undef GRID_BAR
}

extern "C" void kernel_launch(void* const* d_in, const int* in_sizes, int n_in, void* d_out, int out_size, void* d_ws, size_t ws_size, hipStream_t stream) {
    static int grid = 0;
    if (grid == 0) {
        if (n_in != 24 || in_sizes[0] != M * D || out_size != M * D || ws_size < WS_END) { fprintf(stderr, "kernel_launch: unexpected shapes / workspace (%zu < %zu); nothing launched\n", ws_size, (size_t)WS_END); grid = -1; return; }
        int dev = 0, cus = 0, per_cu = 0;
        if (hipGetDevice(&dev) != hipSuccess || hipDeviceGetAttribute(&cus, hipDeviceAttributeMultiprocessorCount, dev) != hipSuccess) { grid = -1; return; }
        if (hipFuncSetAttribute((const void*)mk_fwd, hipFuncAttributeMaxDynamicSharedMemorySize, LDS_BYTES) != hipSuccess) { fprintf(stderr, "kernel_launch: hipFuncSetAttribute failed\n"); grid = -1; return; }
        if (hipOccupancyMaxActiveBlocksPerMultiprocessor(&per_cu, (const void*)mk_fwd, 512, LDS_BYTES) != hipSuccess || per_cu < 1) { fprintf(stderr, "kernel_launch: occupancy query says %d\n", per_cu); }
        (void)hipGetLastError();
        grid = cus;
    }
    if (grid < 0) return;
    if (hipMemsetAsync((char*)d_ws + WS_CTL, 0, CTL_ZERO_BYTES, stream) != hipSuccess) return;
    Args a{};
    for (int i = 0; i < 24; ++i) a.in[i] = (const float*)d_in[i];
    a.out = (float*)d_out; a.ws = (unsigned char*)d_ws;
    if (N_LAUNCHES == 1) {
        a.ph_lo = 0; a.ph_hi = N_PHASES; a.li = 0;
        hipLaunchKernelGGL(mk_fwd, dim3(grid), dim3(512), LDS_BYTES, stream, a);
    } else {
        for (int li = 0; li < N_PHASES; ++li) { a.ph_lo = li; a.ph_hi = li + 1; a.li = li; hipLaunchKernelGGL(mk_fwd, dim3(grid), dim3(512), LDS_BYTES, stream, a); }
    }
}
```

```cpp
#include <hip/hip_runtime.h>
#include <cstdio>
#include <cstdint>

#define LAS __attribute__((address_space(3)))
#define GAS __attribute__((address_space(1)))
typedef unsigned short bf16_t;
typedef short bf16x8 __attribute__((ext_vector_type(8)));
typedef short s16x4 __attribute__((ext_vector_type(4)));
typedef float f32x2 __attribute__((ext_vector_type(2)));
typedef float f32x4 __attribute__((ext_vector_type(4)));
typedef float f32x16 __attribute__((ext_vector_type(16)));
typedef unsigned u32x2 __attribute__((ext_vector_type(2)));
typedef unsigned u32x4 __attribute__((ext_vector_type(4)));
typedef GAS unsigned gu32;
typedef int i32x4 __attribute__((ext_vector_type(4)));
typedef int i32x8 __attribute__((ext_vector_type(8)));
constexpr float W8SCALE = 32.f;
constexpr int W8_MFMA_SCALE = 0x7a7a7a7a;
constexpr float CGATE = 1.702f * 1.4426950408889634f;

#ifndef MK_N_LAUNCHES
#define MK_N_LAUNCHES 1
#endif
#ifndef REP_EPI
#define REP_EPI 0
#endif
#ifndef REP_P0
#define REP_P0 1
#endif
#ifndef STAG_P1
#define STAG_P1 2
#endif
#ifndef REP_P8
#define REP_P8 1
#endif
#ifndef REP_CV
#define REP_CV 1
#endif
#ifndef REP_CONV
#define REP_CONV 1
#endif
#ifndef REP_NULL
#define REP_NULL 0
#endif
#ifndef REP_P1
#define REP_P1 1
#endif
#ifndef REP_CONV
#define REP_CONV 1
#endif
#ifndef REP_P3
#define REP_P3 1
#endif
#ifndef REP_P4
#define REP_P4 1
#endif
#ifndef REP_P5B
#define REP_P5B 1
#endif
#ifndef REP_P6
#define REP_P6 1
#endif
#ifndef REP_P7
#define REP_P7 1
#endif
constexpr int N_PHASES = 9;
constexpr int N_LAUNCHES = MK_N_LAUNCHES;

constexpr int BATCH = 8, SEQ = 4096, D = 1024, M = BATCH * SEQ, NIN = 5376, NE = 32, KCONV = 31;
constexpr float EPS = 1e-5f;
constexpr float LOG2E = 1.4426950408889634f;
constexpr float QSCALE = 0.125f * LOG2E;
constexpr int LIST_CAP = 32768;

constexpr size_t MiB = 1u << 20;
constexpr size_t WS_CTL = 0, CTL_ZERO_BYTES = 128 * 1024;
constexpr size_t WS_LIST = 1 * MiB;
constexpr size_t WS_TOKW = 5 * MiB;
constexpr size_t WS_RSTD1 = 5 * MiB + 512 * 1024;
constexpr size_t WS_RSTD2 = WS_RSTD1 + 128 * 1024;
constexpr size_t WS_BPERM = WS_RSTD2 + 128 * 1024;
constexpr size_t WS_WRT = 6 * MiB;
constexpr size_t WS_R1 = 7 * MiB;
constexpr size_t WS_U = WS_R1, WS_QO = WS_R1 + 64 * MiB, WS_KV = WS_R1 + 128 * MiB, WS_RR = WS_R1 + 144 * MiB, WS_GA = WS_R1 + 208 * MiB;
constexpr size_t WS_MIX = WS_U;
constexpr size_t WS_ACT = WS_R1;
constexpr size_t WS_X1F8 = WS_R1 + 136 * MiB;
constexpr size_t WS_Y = WS_R1 + 136 * MiB;
constexpr size_t WS_ROWOF = 6 * MiB + 256 * 1024;
constexpr size_t WS_R2 = 279 * MiB;
constexpr size_t WS_R4 = 343 * MiB;
constexpr size_t WS_WIN = 503 * MiB, WS_WCO = WS_WIN + 11 * MiB, WS_WAO = WS_WIN + 13 * MiB, WS_WO = WS_WIN + 15 * MiB;
constexpr size_t WS_WGU = WS_R4, WS_YB = WS_R4;
constexpr size_t WS_WD = 471 * MiB;
constexpr size_t WS_END = 535 * MiB;

constexpr int CW_BAR = 4096;
constexpr int CW_GCNT = 16384;

constexpr int RING_BYTES = 131072;
constexpr int MISC_OFF = RING_BYTES;
constexpr int MISC_XB = 0;
constexpr int MISC_CPRE = 64;
constexpr int MISC_TBL = 256;
constexpr int MISC_UTAB = 512;
constexpr int MISC_HIST = 512, MISC_SBASE = 640;
constexpr int MISC_ETAB = 1024, MISC_LTAB = 3072;
constexpr int MISC_IDX = 8192;
constexpr int IDX_SLOTS = 18;
constexpr int LDS_BYTES = RING_BYTES + 8192 + IDX_SLOTS * 1024;

#define RLX_AGENT __ATOMIC_RELAXED, __HIP_MEMORY_SCOPE_AGENT
#define LDS_WAIT() asm volatile("s_waitcnt lgkmcnt(0)" ::: "memory")
#define VM_WAIT() asm volatile("s_waitcnt vmcnt(0)" ::: "memory")
__device__ __forceinline__ unsigned cvt_pk_bf16(float lo, float hi) { unsigned r; asm volatile("v_cvt_pk_bf16_f32 %0, %1, %2" : "=v"(r) : "v"(lo), "v"(hi)); return r; }
__device__ __forceinline__ float bf_lo(unsigned w) { return __uint_as_float(w << 16); }
__device__ __forceinline__ float bf_hi(unsigned w) { return __uint_as_float(w & 0xffff0000u); }
__device__ __forceinline__ float fast_exp2(float x) { return __builtin_amdgcn_exp2f(x); }
__device__ __forceinline__ float fast_rcp(float x) { return __builtin_amdgcn_rcpf(x); }
__device__ __forceinline__ float sigmoid_f(float x) { return fast_rcp(1.f + fast_exp2(-LOG2E * x)); }
__device__ __forceinline__ float wave_sum(float v) {
#pragma unroll
    for (int o = 1; o < 64; o <<= 1) v += __shfl_xor(v, o);
    return v;
}
__device__ __forceinline__ float wave_max(float v) {
#pragma unroll
    for (int o = 1; o < 64; o <<= 1) v = fmaxf(v, __shfl_xor(v, o));
    return v;
}
__device__ __forceinline__ unsigned pack4_fp8(float a, float b, float c, float d) { int v = 0; v = __builtin_amdgcn_cvt_pk_fp8_f32(a, b, v, false); v = __builtin_amdgcn_cvt_pk_fp8_f32(c, d, v, true); return (unsigned)v; }
__device__ __forceinline__ u32x4 pack8(f32x4 a, f32x4 b) { u32x4 w; w.x = cvt_pk_bf16(a[0], a[1]); w.y = cvt_pk_bf16(a[2], a[3]); w.z = cvt_pk_bf16(b[0], b[1]); w.w = cvt_pk_bf16(b[2], b[3]); return w; }

#define XB_TMO      128
#define XB_XCNT(j)  (256  + 64 * (j))
#define XB_XSUB(j)  (1280 + 64 * (j))
#define XB_XGEN(j)  (2304 + 64 * (j))
#define XB_TOP      3328
#define XB_TOPGEN   3392
#define XCD_BAR_WORDS 3456
#define XB_SPIN_CAP (1u << 18)

__device__ __forceinline__ unsigned xb_ld(unsigned* p)              { return __hip_atomic_load(p, __ATOMIC_RELAXED, __HIP_MEMORY_SCOPE_AGENT); }
__device__ __forceinline__ unsigned xb_add(unsigned* p, unsigned v) { return __hip_atomic_fetch_add(p, v, __ATOMIC_RELAXED, __HIP_MEMORY_SCOPE_AGENT); }
__device__ __forceinline__ unsigned xb_xcc_id() { return (unsigned)__builtin_amdgcn_s_getreg((3 << 11) | 20) & 0xFu; }
#define XB_SPIN(cond, bar) do { unsigned _sp = 0; while (cond) { __builtin_amdgcn_s_sleep(1); \
    if ((++_sp & 255u) == 0u) { if (xb_ld(&(bar)[XB_TMO])) break; if (_sp > XB_SPIN_CAP) { atomicAdd(&(bar)[XB_TMO], 1u); break; } } } } while (0)

struct XcdBarrier { unsigned* bar; unsigned x; volatile LAS unsigned* st; };

__device__ __forceinline__ XcdBarrier xcd_barrier_post(unsigned* bar, volatile LAS unsigned* st) {
    XcdBarrier b; b.bar = bar; b.x = xb_xcc_id(); b.st = st;
    if (threadIdx.x == 0) (void)xb_add(&bar[XB_XCNT(b.x)], 1u);
    return b;
}
__device__ __forceinline__ void xcd_barrier_complete(unsigned* bar, unsigned x, unsigned& nloc, unsigned& nx) {
    const unsigned G = gridDim.x * gridDim.y * gridDim.z;
    unsigned sum, cnt, mine, sp = 0u;
    for (;;) {
        sum = 0u; cnt = 0u; mine = 0u;
#pragma unroll
        for (unsigned j = 0; j < 16; ++j) { const unsigned c = xb_ld(&bar[XB_XCNT(j)]); sum += c; cnt += (c > 0u) ? 1u : 0u; mine = (j == x) ? c : mine; }
        if (sum == G) break;
        __builtin_amdgcn_s_sleep(1);
        if ((++sp & 255u) == 0u) { if (xb_ld(&bar[XB_TMO])) break; if (sp > XB_SPIN_CAP) { atomicAdd(&bar[XB_TMO], 1u); break; } }
    }
    nloc = mine > 0u ? mine : 1u; nx = cnt > 0u ? cnt : 1u;
}
__device__ __forceinline__ void xcd_barrier(const XcdBarrier& b) {
    asm volatile("s_waitcnt vmcnt(0)" ::: "memory");
    __syncthreads();
    if (threadIdx.x == 0) {
        unsigned* bar = b.bar;
        __builtin_amdgcn_s_waitcnt(0);
        unsigned nloc = b.st[0], nx = b.st[1];
        if (nloc == 0u) { xcd_barrier_complete(bar, b.x, nloc, nx); b.st[0] = nloc; b.st[1] = nx; }
        const unsigned old = xb_add(&bar[XB_XSUB(b.x)], 1u);
        const unsigned gen = old / nloc;
        if (old + 1u == (gen + 1u) * nloc) {
            __builtin_amdgcn_fence(__ATOMIC_RELEASE, "agent");
            asm volatile("s_waitcnt vmcnt(0)" ::: "memory");
            const unsigned og = xb_add(&bar[XB_TOP], 1u);
            const unsigned tg = og / nx;
            if (og + 1u == (tg + 1u) * nx) xb_add(&bar[XB_TOPGEN], 1u);
            else XB_SPIN(xb_ld(&bar[XB_TOPGEN]) == tg, bar);
            __builtin_amdgcn_fence(__ATOMIC_ACQUIRE, "agent");
            xb_add(&bar[XB_XGEN(b.x)], 1u);
            asm volatile("s_waitcnt vmcnt(0)" ::: "memory");
        } else {
            XB_SPIN(xb_ld(&bar[XB_XGEN(b.x)]) == gen, bar);
            __builtin_amdgcn_fence(__ATOMIC_ACQUIRE, "agent");
            asm volatile("s_waitcnt vmcnt(0)" ::: "memory");
        }
    }
    __syncthreads();
}

namespace mg {
constexpr int BM = 256, BK = 64, HALF = 128, HTB = HALF * BK * 2, K = 1024, NXCD = 8, WGM = 8;
__host__ __device__ __forceinline__ int lds_byte(int r, int c) { const int st = (r >> 4) * 2 + (c >> 5), rr = r & 15, cc = c & 31, ob = rr * 64 + cc * 2; return st * 1024 + (ob ^ (((ob >> 9) & 1) << 5)); }
__host__ __device__ __forceinline__ void stage_rc(int b, int& R, int& C) { const int st = b / 1024, sb = b % 1024, swz = sb ^ (((sb >> 9) & 1) << 5); R = (st >> 1) * 16 + swz / 64; C = (st & 1) * 32 + (swz % 64) / 2; }
__host__ __device__ __forceinline__ int perm32(int rho) { const int n = rho >> 4, i = rho & 15; return 8 * (i >> 2) + 4 * n + (i & 3); }

struct GUnit { const char* A; const char* B; int slot, pm, pn, aux, lslot; };

struct StaticOrder {
    int nM, nN, nwg, G, c;
    __device__ void init(int M_, int N_, int G_, int c_) { nM = M_ / BM; nN = N_ / BM; nwg = nM * nN; G = G_; c = c_; }
    __device__ bool next(int i, int& pm, int& pn) const {
        const long L = (long)i * G + c; if (L >= nwg) return false;
        int wgid = (int)L; { const int q = nwg / NXCD, r = nwg % NXCD, xcd = wgid % NXCD, off = wgid / NXCD; wgid = (xcd < r ? xcd * (q + 1) : r * (q + 1) + (xcd - r) * q) + off; }
        const int nig = WGM * nN, gid = wgid / nig, fm = gid * WGM, gsz = (nM - fm) < WGM ? (nM - fm) : WGM;
        pm = fm + ((wgid % nig) % gsz); pn = (wgid % nig) / gsz; return true;
    }
};

template <int ROWB, bool GATHER> __device__ __forceinline__ void unit_offs(LAS unsigned char* lds, const GUnit& u, const int (&RA)[2], const int (&CA2)[2], unsigned (&o0)[2], unsigned (&o1)[2]) {
#pragma unroll
    for (int i = 0; i < 2; ++i) {
        int r0 = RA[i], r1 = HALF + RA[i];
        if constexpr (GATHER) { if (u.slot >= 0) { const LAS int* ix = (const LAS int*)(lds + MISC_OFF + MISC_IDX) + u.slot * 256; const int e0 = ix[r0], e1 = ix[r1]; r0 = e0 < 0 ? 0 : (e0 >> 2); r1 = e1 < 0 ? 0 : (e1 >> 2); } else { r0 += u.pm * 256; r1 += u.pm * 256; } }
        o0[i] = (unsigned)r0 * (unsigned)ROWB + (unsigned)CA2[i]; o1[i] = (unsigned)r1 * (unsigned)ROWB + (unsigned)CA2[i];
    }
}

template <class Epi, class Sched>
__device__ __forceinline__ void gemm_phase(LAS unsigned char* lds, const Sched& S, const Epi& E) {
    constexpr int ROWB = Epi::ROWB, NT = ROWB / 128; constexpr bool GATHER = Sched::GATHER;
    const int tid = threadIdx.x, wid = __builtin_amdgcn_readfirstlane(tid >> 6), lane = tid & 63, wr = wid >> 2, wc = wid & 3, fr = lane & 15, fq = lane >> 4;
    int RA[2], CA2[2]; unsigned voffB[2];
#pragma unroll
    for (int i = 0; i < 2; ++i) { int R, C; stage_rc(tid * 16 + i * 8192, R, C); const int Rb = (Epi::PERM64) ? (64 * (R >> 5) + 16 * ((R >> 2) & 3) + 4 * ((R >> 4) & 1) + (R & 3)) : Epi::PERM ? ((R & ~31) + perm32(R & 31)) : R;
        RA[i] = R; CA2[i] = C * 2; voffB[i] = (unsigned)(Rb * ROWB + C * 2); }
    constexpr size_t kstep = (size_t)(BK * 2);
    constexpr size_t hstepB = (size_t)(Epi::PERM64 ? 8 : HALF) * ROWB;
    const unsigned ldsw = (unsigned)wid * 1024u;
    const int aoff = lds_byte(wr * 64 + fr, fq * 8), boff = lds_byte(wc * 32 + fr, fq * 8);
#define MG_SA(b, h) (((b) * 2 + (h)) * HTB)
#define MG_SB(b, h) ((4 + (b) * 2 + (h)) * HTB)
#define MG_STAGE(bufoff, gbase, voff) do { _Pragma("unroll") for (int _i = 0; _i < 2; ++_i) \
        __builtin_amdgcn_global_load_lds((const unsigned*)((const char*)(gbase) + (voff)[_i]), (LAS unsigned*)(lds + (bufoff) + ldsw + _i * 8192), 16, 0, 0); } while (0)
#define MG_LDA(dst, b, h) do { _Pragma("unroll") for (int m = 0; m < 4; ++m) { const i32x4 lo_ = *(const LAS i32x4*)(lds + MG_SA(b, h) + aoff + m * 2048), hi_ = *(const LAS i32x4*)(lds + MG_SA(b, h) + aoff + m * 2048 + 1024); dst[m] = __builtin_shufflevector(lo_, hi_, 0, 1, 2, 3, 4, 5, 6, 7); } } while (0)
#define MG_LDB(dst, b, h) do { _Pragma("unroll") for (int n = 0; n < 2; ++n) { const i32x4 lo_ = *(const LAS i32x4*)(lds + MG_SB(b, h) + boff + n * 2048), hi_ = *(const LAS i32x4*)(lds + MG_SB(b, h) + boff + n * 2048 + 1024); dst[n] = __builtin_shufflevector(lo_, hi_, 0, 1, 2, 3, 4, 5, 6, 7); } } while (0)
#define MG_MMA(ai, bj, At, Bt) do { __builtin_amdgcn_s_setprio(1); _Pragma("unroll") for (int m = 0; m < 4; ++m) _Pragma("unroll") for (int n = 0; n < 2; ++n) { \
        if constexpr (Epi::F8) { acc[ai][bj][m][n] = __builtin_amdgcn_mfma_scale_f32_16x16x128_f8f6f4(Bt[n], At[m], acc[ai][bj][m][n], 0, 0, 0, W8_MFMA_SCALE, 0, 0x7f7f7f7f); } \
        else { acc[ai][bj][m][n] = __builtin_amdgcn_mfma_f32_16x16x32_bf16(__builtin_bit_cast(bf16x8, __builtin_shufflevector(Bt[n], Bt[n], 0, 1, 2, 3)), __builtin_bit_cast(bf16x8, __builtin_shufflevector(At[m], At[m], 0, 1, 2, 3)), acc[ai][bj][m][n], 0, 0, 0); \
               acc[ai][bj][m][n] = __builtin_amdgcn_mfma_f32_16x16x32_bf16(__builtin_bit_cast(bf16x8, __builtin_shufflevector(Bt[n], Bt[n], 4, 5, 6, 7)), __builtin_bit_cast(bf16x8, __builtin_shufflevector(At[m], At[m], 4, 5, 6, 7)), acc[ai][bj][m][n], 0, 0, 0); } } \
        __builtin_amdgcn_s_setprio(0); } while (0)
#define MG_WAIT_V(n) asm volatile("s_waitcnt vmcnt(" #n ")" ::: "memory")
#define MG_WAIT_L(n) asm volatile("s_waitcnt lgkmcnt(" #n ")" ::: "memory")
#define MG_BAR __builtin_amdgcn_s_barrier()
#define MG_SCHED __builtin_amdgcn_sched_barrier(0)
    GUnit cur, nxt; int ui = 0;
    if (!S.next(0, cur)) return;
    f32x4 acc[2][2][4][2];
    E.init(acc, cur, wr, wc, fr, fq);
    i32x8 At[4], B0[2], B1[2];
    unsigned cA0[2], cA1[2];
    unit_offs<ROWB, GATHER>(lds, cur, RA, CA2, cA0, cA1);
    const char* cAp = cur.A; const char* cBp = cur.B;
    MG_STAGE(MG_SB(0, 0), cBp, voffB); MG_STAGE(MG_SB(0, 1), cBp + hstepB, voffB); MG_STAGE(MG_SA(0, 0), cAp, cA0); MG_STAGE(MG_SA(0, 1), cAp, cA1);
    if (wr == 1) MG_BAR;
    MG_WAIT_V(2); MG_BAR;
    MG_STAGE(MG_SB(1, 0), cBp + kstep, voffB); MG_STAGE(MG_SA(1, 0), cAp + kstep, cA0); MG_STAGE(MG_SB(1, 1), cBp + hstepB + kstep, voffB);
    MG_WAIT_V(6); MG_BAR;
    for (;;) {
        const bool has_next = S.next(ui + 1, nxt);
        const char* nAp = has_next ? nxt.A : cAp; const char* nBp = has_next ? nxt.B : cBp;
#pragma unroll 1
        for (int t = 0; t < NT; t += 2) {
            const bool last = (t == NT - 2);
            const char* a1 = cAp + (size_t)(t + 1) * kstep;
            const char* a2 = last ? nAp : cAp + (size_t)(t + 2) * kstep; const char* b2 = last ? nBp : cBp + (size_t)(t + 2) * kstep;
            const char* a3 = a2 + kstep; const char* b3 = b2 + kstep;
            MG_LDB(B0, 0, 0); MG_LDB(B1, 0, 1); MG_SCHED; MG_LDA(At, 0, 0); MG_STAGE(MG_SA(1, 1), a1, cA1);
            if constexpr (GATHER) { if (last && has_next) unit_offs<ROWB, GATHER>(lds, nxt, RA, CA2, cA0, cA1); }
            MG_WAIT_V(8); MG_WAIT_L(0); MG_BAR; MG_MMA(0, 0, At, B0); MG_MMA(0, 1, At, B1); MG_BAR; MG_SCHED;
            MG_LDA(At, 0, 1); MG_STAGE(MG_SB(0, 0), b2, voffB); MG_STAGE(MG_SB(0, 1), b2 + hstepB, voffB); MG_STAGE(MG_SA(0, 0), a2, cA0);
            MG_WAIT_V(8); MG_WAIT_L(0); MG_BAR; MG_MMA(1, 0, At, B0); MG_MMA(1, 1, At, B1); MG_BAR; MG_SCHED;
            MG_LDB(B0, 1, 0); MG_LDB(B1, 1, 1); MG_SCHED; MG_LDA(At, 1, 0); MG_STAGE(MG_SA(0, 1), a2, cA1);
            MG_WAIT_V(8); MG_WAIT_L(0); MG_BAR; MG_MMA(0, 0, At, B0); MG_MMA(0, 1, At, B1); MG_BAR; MG_SCHED;
            MG_LDA(At, 1, 1); MG_STAGE(MG_SB(1, 0), b3, voffB); MG_STAGE(MG_SB(1, 1), b3 + hstepB, voffB); MG_STAGE(MG_SA(1, 0), a3, cA0);
            MG_WAIT_V(8); MG_WAIT_L(0); MG_BAR; MG_MMA(1, 0, At, B0); MG_MMA(1, 1, At, B1); MG_BAR; MG_SCHED;
        }
        if (wr == 0) MG_BAR;
        E(acc, cur, nxt, has_next, wr, wc, fr, fq);
        if (!has_next) break;
        cur = nxt; cAp = nAp; cBp = nBp; ++ui;
        if (wr == 1) MG_BAR;
    }
    MG_WAIT_V(0);
    MG_BAR;
#undef MG_SA
#undef MG_SB
#undef MG_STAGE
#undef MG_LDA
#undef MG_LDB
#undef MG_MMA
#undef MG_WAIT_V
#undef MG_WAIT_L
#undef MG_BAR
#undef MG_SCHED
}

template <int ROWB = 2048> struct DenseSched {
    static constexpr bool GATHER = (ROWB == 1024);
    StaticOrder so; const char* A; const char* Bt;
    __device__ __forceinline__ bool next(int i, GUnit& u) const {
        int pm, pn; if (!so.next(i, pm, pn)) return false;
        u.A = GATHER ? A : A + (size_t)pm * (256 * ROWB); u.B = Bt + (size_t)pn * (256 * ROWB); u.slot = GATHER ? -1 : 0; u.lslot = 0; u.pm = pm; u.pn = pn; u.aux = 0; return true;
    }
};
struct MixSched {
    static constexpr bool GATHER = false;
    StaticOrder so; const char* A0; const char* A1; const char* B0; const char* B1;
    __device__ __forceinline__ bool next(int s, GUnit& u) const {
        int pm, pn; if (!so.next(s >> 1, pm, pn)) return false;
        const int part = s & 1;
        u.A = (part ? A1 : A0) + (size_t)pm * (256 * K * 2); u.B = (part ? B1 : B0) + (size_t)pn * (256 * K * 2); u.slot = 0; u.lslot = 0; u.pm = pm; u.pn = pn; u.aux = part; return true;
    }
};
template <int NCOL, bool GATHER_, int ROWB> struct MoeSched {
    static constexpr bool GATHER = true;
    const LAS int* tbl; int j, G; const char* A; const char* Bt; const int* list;
    __device__ __forceinline__ void preload(LAS unsigned char* lds, int tid) const {
        LAS int* ut = (LAS int*)(lds + MISC_OFF + MISC_UTAB);
        if (tid < IDX_SLOTS) {
            const int total = tbl[NE] * NCOL, Lg = tid * G + j; int e = -1, lrt = 0, rt = 0, pn = 0;
            if (Lg < total) { rt = Lg / NCOL; pn = Lg % NCOL; e = 0; for (int q = 1; q < NE; ++q) e += (tbl[q] <= rt) ? 1 : 0; lrt = rt - tbl[e]; }
            ut[tid * 4 + 0] = e; ut[tid * 4 + 1] = lrt; ut[tid * 4 + 2] = rt; ut[tid * 4 + 3] = pn;
        }
        LDS_WAIT(); __syncthreads();
        LAS int* ix = (LAS int*)(lds + MISC_OFF + MISC_IDX);
        if (GATHER_ && tid < 256) { int vals[IDX_SLOTS];
#pragma unroll
            for (int i = 0; i < IDX_SLOTS; ++i) { const int e = ut[i * 4]; vals[i] = (e >= 0) ? list[(size_t)e * LIST_CAP + ut[i * 4 + 1] * 256 + tid] : -1; }
#pragma unroll
            for (int i = 0; i < IDX_SLOTS; ++i) ix[i * 256 + tid] = vals[i]; }
        LDS_WAIT(); __syncthreads();
    }
    __device__ __forceinline__ bool next(int i, GUnit& u) const {
        if (i >= IDX_SLOTS) return false;
        const LAS int* ut = (const LAS int*)(tbl) + (MISC_UTAB - MISC_TBL) / 4 + i * 4;
        const int e = __builtin_amdgcn_readfirstlane(ut[0]); if (e < 0) return false;
        const int rt = __builtin_amdgcn_readfirstlane(ut[2]), pn = __builtin_amdgcn_readfirstlane(ut[3]);
        u.A = A; u.B = Bt + ((size_t)e * NCOL + pn) * (256 * ROWB);
        u.slot = GATHER_ ? i : -1; u.lslot = i; u.pm = rt; u.pn = pn; u.aux = e; return true;
    }
};

#define FOR_AI_M _Pragma("unroll") for (int ai = 0; ai < 2; ++ai) _Pragma("unroll") for (int m = 0; m < 4; ++m)
#define FOR_BJ_N _Pragma("unroll") for (int bj = 0; bj < 2; ++bj) _Pragma("unroll") for (int n = 0; n < 2; ++n)
__device__ __forceinline__ void acc_fill(f32x4 (&acc)[2][2][4][2], const f32x4 (&bv)[2][2]) { FOR_AI_M { FOR_BJ_N acc[ai][bj][m][n] = bv[bj][n]; } }
template <bool ST> struct EpiInT {
    static constexpr bool PERM = true, PERM64 = false, F8 = true; static constexpr int ROWB = 1024, ID = 1;
    const float* bperm; bf16_t *U, *Q, *KV, *RR, *GA; int opq;
    __device__ __forceinline__ void load_bias(f32x4 (&bv)[2][2], int pn, int wc, int fq) const { const int cw = wc * 32 + 8 * fq; FOR_BJ_N bv[bj][n] = *(const f32x4*)(bperm + pn * 256 + bj * 128 + cw + 4 * n); }
    __device__ __forceinline__ void init(f32x4 (&acc)[2][2][4][2], const GUnit& u, int wr, int wc, int fr, int fq) const { f32x4 bv[2][2]; load_bias(bv, u.pn, wc, fq); acc_fill(acc, bv); }
    __device__ __forceinline__ void operator()(f32x4 (&acc)[2][2][4][2], const GUnit& u, const GUnit& nx, bool has_next, int wr, int wc, int fr, int fq) const {
        const int pn = u.pn, row0 = u.pm * 256 + wr * 64 + fr, cw = wc * 32 + 8 * fq;
        f32x4 nb[2][2]; load_bias(nb, has_next ? nx.pn : pn, wc, fq);
        const size_t gbase = ((size_t)(u.pm * 8 + (pn - 13)) * 64 + (size_t)((wr * 4 + wc) * 8)) * 512 + (size_t)(fq * 16 + fr) * 8;
        FOR_AI_M {
            const int row = row0 + ai * 128 + m * 16;
            if (pn < 8) {
                f32x4 r[2];
#pragma unroll
                for (int n = 0; n < 2; ++n) { const f32x4 a = acc[ai][0][m][n], b = acc[ai][1][m][n]; f32x4 e;
#pragma unroll
                    for (int j = 0; j < 4; ++j) e[j] = fast_exp2(-b[j]);
                    e = e + 1.f;
#pragma unroll
                    for (int j = 0; j < 4; ++j) e[j] = fast_rcp(e[j]);
                    r[n] = a * e; }
                { const u32x4 pk = pack8(r[0], r[1]); if constexpr (!ST) asm volatile("" :: "v"(pk)); if (ST || opq) *(u32x4*)(U + (size_t)row * D + pn * 128 + cw) = pk; }
            } else if (pn < 12) {
#pragma unroll
                for (int bj = 0; bj < 2; ++bj) { const u32x4 pk = pack8(acc[ai][bj][m][0], acc[ai][bj][m][1]); if constexpr (!ST) asm volatile("" :: "v"(pk)); if (ST || opq) *(u32x4*)(Q + (size_t)row * D + (pn - 8) * 256 + bj * 128 + cw) = pk; }
            } else if (pn == 12) {
#pragma unroll
                for (int bj = 0; bj < 2; ++bj) { const u32x4 pk = pack8(acc[ai][bj][m][0], acc[ai][bj][m][1]); if constexpr (!ST) asm volatile("" :: "v"(pk)); if (ST || opq) *(u32x4*)(KV + (size_t)row * 256 + bj * 128 + cw) = pk; }
            } else {
                f32x4 rr[2], ga[2];
#pragma unroll
                for (int n = 0; n < 2; ++n) {
                    f32x4 ea, eb;
#pragma unroll
                    for (int j = 0; j < 4; ++j) { ea[j] = fast_exp2(-__builtin_amdgcn_fmed3f(acc[ai][0][m][n][j], -60.f, 60.f)); eb[j] = fast_exp2(-__builtin_amdgcn_fmed3f(acc[ai][1][m][n][j], -60.f, 60.f)); }
                    ea = ea + 1.f; eb = eb + 1.f;
                    f32x4 ia, ib;
#pragma unroll
                    for (int j = 0; j < 4; ++j) { ia[j] = fast_rcp(ea[j]); ib[j] = fast_rcp(eb[j]); }
                    ga[n] = ib; rr[n] = eb * ia;
                }
                const size_t o = gbase + (size_t)((ai * 4 + m) * 512);
                { const u32x4 p0 = pack8(rr[0], rr[1]), p1 = pack8(ga[0], ga[1]); if constexpr (!ST) asm volatile("" :: "v"(p0), "v"(p1)); if (ST || opq) { __builtin_nontemporal_store(p0, (u32x4*)(RR + o)); __builtin_nontemporal_store(p1, (u32x4*)(GA + o)); } }
            }
            FOR_BJ_N acc[ai][bj][m][n] = nb[bj][n];
        }
    }
};
using EpiIn = EpiInT<true>;
struct EpiMix {
    static constexpr bool PERM = true, PERM64 = false, F8 = false; static constexpr int ROWB = 2048, ID = 3;
    const bf16_t *RR, *GA; const float *bco, *bao; bf16_t* MIX;
    __device__ __forceinline__ void load_bias(f32x4 (&bv)[2][2], const float* bias, int pn, int wc, int fq) const { const int c0 = pn * 256 + wc * 32 + 8 * fq; FOR_BJ_N bv[bj][n] = *(const f32x4*)(bias + c0 + bj * 128 + 4 * n); }
    __device__ __forceinline__ void init(f32x4 (&acc)[2][2][4][2], const GUnit& u, int wr, int wc, int fr, int fq) const { f32x4 bv[2][2]; load_bias(bv, bco, u.pn, wc, fq); acc_fill(acc, bv); }
    __device__ __forceinline__ void operator()(f32x4 (&acc)[2][2][4][2], const GUnit& u, const GUnit& nx, bool has_next, int wr, int wc, int fr, int fq) const {
        const int row0 = u.pm * 256 + wr * 64 + fr, col0 = u.pn * 256 + wc * 32 + 8 * fq;
        const bool part1 = (u.aux != 0);
        f32x4 nb[2][2]; load_bias(nb, part1 ? bco : bao, part1 ? (has_next ? nx.pn : u.pn) : u.pn, wc, fq);
        const bf16_t* Gb = (part1 ? GA : RR) + ((size_t)(u.pm * 8 + 2 * u.pn) * 64 + (size_t)((wr * 4 + wc) * 8)) * 512 + (size_t)(fq * 16 + fr) * 8;
        u32x4 gt[2][4][2];
        FOR_AI_M {
#pragma unroll
            for (int bj = 0; bj < 2; ++bj) gt[ai][m][bj] = __builtin_nontemporal_load((const u32x4*)(Gb + (size_t)(bj * 32768 + (ai * 4 + m) * 512))); }
        FOR_AI_M {
            const size_t ro = (size_t)(row0 + ai * 128 + m * 16) * D + col0;
#pragma unroll
            for (int bj = 0; bj < 2; ++bj) {
                const u32x4 g = gt[ai][m][bj];
                const f32x4 g0 = (f32x4){bf_lo(g.x), bf_hi(g.x), bf_lo(g.y), bf_hi(g.y)}, g1 = (f32x4){bf_lo(g.z), bf_hi(g.z), bf_lo(g.w), bf_hi(g.w)};
                if (part1) { *(u32x4*)(MIX + ro + bj * 128) = pack8(acc[ai][bj][m][0] * g0, acc[ai][bj][m][1] * g1); acc[ai][bj][m][0] = nb[bj][0]; acc[ai][bj][m][1] = nb[bj][1]; }
                else { acc[ai][bj][m][0] = acc[ai][bj][m][0] * g0 + nb[bj][0]; acc[ai][bj][m][1] = acc[ai][bj][m][1] * g1 + nb[bj][1]; }
            }
        }
    }
};
struct EpiRes {
    static constexpr bool PERM = true, PERM64 = false, F8 = false; static constexpr int ROWB = 2048, ID = 4;
    const float* x; bf16_t* X1B;
    __device__ __forceinline__ void init(f32x4 (&acc)[2][2][4][2], const GUnit& u, int wr, int wc, int fr, int fq) const { FOR_AI_M { FOR_BJ_N acc[ai][bj][m][n] = (f32x4){0.f, 0.f, 0.f, 0.f}; } }
    __device__ __forceinline__ void operator()(f32x4 (&acc)[2][2][4][2], const GUnit& u, const GUnit& nx, bool has_next, int wr, int wc, int fr, int fq) const {
        const int row0 = u.pm * 256 + wr * 64 + fr, col0 = u.pn * 256 + wc * 32 + 8 * fq;
#pragma unroll
        for (int ai = 0; ai < 2; ++ai) {
            f32x4 xt[4][2][2];
#pragma unroll
            for (int m = 0; m < 4; ++m) { const size_t ro = (size_t)(row0 + ai * 128 + m * 16) * D + col0;
#pragma unroll
                for (int bj = 0; bj < 2; ++bj) { xt[m][bj][0] = __builtin_nontemporal_load((const f32x4*)(x + ro + bj * 128)); xt[m][bj][1] = __builtin_nontemporal_load((const f32x4*)(x + ro + bj * 128 + 4)); } }
#pragma unroll
            for (int m = 0; m < 4; ++m) { const size_t ro = (size_t)(row0 + ai * 128 + m * 16) * D + col0;
#pragma unroll
                for (int bj = 0; bj < 2; ++bj) {
                    *(u32x4*)(X1B + ro + bj * 128) = pack8(xt[m][bj][0] + acc[ai][bj][m][0], xt[m][bj][1] + acc[ai][bj][m][1]);
                    acc[ai][bj][m][0] = (f32x4){0.f, 0.f, 0.f, 0.f}; acc[ai][bj][m][1] = (f32x4){0.f, 0.f, 0.f, 0.f};
                } }
        }
    }
};
struct EpiSwiglu {
    static constexpr bool PERM = true, PERM64 = false, F8 = true; static constexpr int ROWB = 1024, ID = 6;
    const float *bg, *bu; unsigned char* ACT;
    __device__ __forceinline__ void load_bias(f32x4 (&bv)[2][2], int e, int pn, int wc, int fq) const { const int ch0 = pn * 128 + wc * 32 + 8 * fq;
#pragma unroll
        for (int n = 0; n < 2; ++n) { bv[0][n] = *(const f32x4*)(bg + e * D + ch0 + 4 * n) * CGATE; bv[1][n] = *(const f32x4*)(bu + e * D + ch0 + 4 * n) + 1.f; } }
    __device__ __forceinline__ void init(f32x4 (&acc)[2][2][4][2], const GUnit& u, int wr, int wc, int fr, int fq) const { f32x4 bv[2][2]; load_bias(bv, u.aux, u.pn, wc, fq); acc_fill(acc, bv); }
    __device__ __forceinline__ void operator()(f32x4 (&acc)[2][2][4][2], const GUnit& u, const GUnit& nx, bool has_next, int wr, int wc, int fr, int fq) const {
        const int ch0 = u.pn * 128 + wc * 32 + 8 * fq;
        f32x4 nb[2][2]; load_bias(nb, has_next ? nx.aux : u.aux, has_next ? nx.pn : u.pn, wc, fq);
        constexpr float GLIM = 7.f * CGATE;
        FOR_AI_M {
            const int r = ai * 128 + wr * 64 + m * 16 + fr;
            f32x4 a[2];
#pragma unroll
            for (int n = 0; n < 2; ++n) {
                f32x4 gc, uc, e, d;
#pragma unroll
                for (int j = 0; j < 4; ++j) { gc[j] = __builtin_amdgcn_fmed3f(acc[ai][0][m][n][j], -3.0e38f, GLIM); uc[j] = __builtin_amdgcn_fmed3f(acc[ai][1][m][n][j], -6.f, 8.f); }
#pragma unroll
                for (int j = 0; j < 4; ++j) e[j] = fast_exp2(-gc[j]);
                d = e * CGATE + CGATE;
#pragma unroll
                for (int j = 0; j < 4; ++j) d[j] = fast_rcp(d[j]);
                a[n] = (uc * gc) * d;
            }
            u32x2 pk; pk.x = pack4_fp8(a[0][0], a[0][1], a[0][2], a[0][3]); pk.y = pack4_fp8(a[1][0], a[1][1], a[1][2], a[1][3]);
            *(u32x2*)(ACT + (size_t)(u.pm * 256 + r) * D + ch0) = pk;
            FOR_BJ_N acc[ai][bj][m][n] = nb[bj][n];
        }
    }
};
struct EpiDown {
    static constexpr bool PERM = true, PERM64 = true, F8 = true; static constexpr int ROWB = 1024, ID = 7, NST = 0;
    const LAS int* misc; const float* bd; unsigned char* Y;
    __device__ __forceinline__ void load_bias(f32x4 (&bv)[2][2], int e, int pn, int wc, int fq) const { const int c0 = pn * 256 + wc * 64 + 16 * fq; FOR_BJ_N bv[bj][n] = *(const f32x4*)(bd + e * D + c0 + 8 * bj + 4 * n); }
    __device__ __forceinline__ void init(f32x4 (&acc)[2][2][4][2], const GUnit& u, int wr, int wc, int fr, int fq) const { f32x4 bv[2][2]; load_bias(bv, u.aux, u.pn, wc, fq); acc_fill(acc, bv); }
    __device__ __forceinline__ void operator()(f32x4 (&acc)[2][2][4][2], const GUnit& u, const GUnit& nx, bool has_next, int wr, int wc, int fr, int fq) const {
        const int col0 = u.pn * 256 + wc * 64 + 16 * fq;
        const int c0 = __builtin_amdgcn_readfirstlane(misc[MISC_CPRE / 4 + u.aux]), c1 = __builtin_amdgcn_readfirstlane(misc[MISC_CPRE / 4 + u.aux + 1]);
        const int lr0 = 256 * __builtin_amdgcn_readfirstlane(misc[MISC_UTAB / 4 + u.lslot * 4 + 1]);
        const int drow0 = c0 + lr0, nvalid = c1 - c0 - lr0;
        f32x4 nb[2][2]; load_bias(nb, has_next ? nx.aux : u.aux, has_next ? nx.pn : u.pn, wc, fq);
        FOR_AI_M {
            const int r = ai * 128 + wr * 64 + m * 16 + fr;
            const int drow = (r < nvalid) ? drow0 + r : 4 * M;
            u32x4 pk;
#pragma unroll
            for (int bj = 0; bj < 2; ++bj) { const f32x4 v0 = acc[ai][bj][m][0], v1 = acc[ai][bj][m][1];
                pk[2 * bj] = pack4_fp8(v0[0], v0[1], v0[2], v0[3]); pk[2 * bj + 1] = pack4_fp8(v1[0], v1[1], v1[2], v1[3]); }
            *(u32x4*)(Y + (size_t)drow * 1024 + col0) = pk;
            FOR_BJ_N acc[ai][bj][m][n] = nb[bj][n];
        }
    }
};
template <class B> struct EpiNull {
    static constexpr bool PERM = B::PERM, PERM64 = B::PERM64, F8 = B::F8; static constexpr int ROWB = B::ROWB, ID = B::ID;
    B b;
    __device__ __forceinline__ void init(f32x4 (&acc)[2][2][4][2], const GUnit& u, int wr, int wc, int fr, int fq) const { b.init(acc, u, wr, wc, fr, fq); }
    __device__ __forceinline__ void operator()(f32x4 (&acc)[2][2][4][2], const GUnit& u, const GUnit& nx, bool has_next, int wr, int wc, int fr, int fq) const {
        FOR_AI_M { FOR_BJ_N asm volatile("" :: "v"(acc[ai][bj][m][n])); }
        b.init(acc, has_next ? nx : u, wr, wc, fr, fq);
    }
};
#undef FOR_AI_M
#undef FOR_BJ_N
}

struct Args { const float* in[24]; float* out; unsigned char* ws; int ph_lo, ph_hi, li, pad; };
enum { I_X = 0, I_GMIX, I_WIN, I_BIN, I_CONVW, I_CONVB, I_LNG, I_LNB, I_WCO, I_BCO, I_SINKS, I_WAO, I_BAO, I_WOUT, I_GFFN, I_WR, I_BR, I_WG, I_BG, I_WU, I_BU, I_WD, I_BD, I_GFIN };

__device__ __forceinline__ void tr_item(const float* W, int ldw, int k0, int scol0, const float* gscale, bf16_t* WT, int drow0, LAS float* scr, int lane) {
    const int kr = lane >> 3, nc = lane & 7;
#pragma unroll
    for (int it = 0; it < 8; ++it) {
        const int kk = 8 * it + kr; const f32x4 v = __builtin_nontemporal_load((const f32x4*)(W + (size_t)(k0 + kk) * ldw + scol0 + 4 * nc));
        const float g = gscale ? gscale[k0 + kk] : 1.f;
        LAS float* s = scr + kk * 33 + 4 * nc; s[0] = v[0] * g; s[1] = v[1] * g; s[2] = v[2] * g; s[3] = v[3] * g;
    }
    LDS_WAIT(); asm volatile("" ::: "memory");
    const int c = lane & 7;
#pragma unroll
    for (int j = 0; j < 4; ++j) { const int n = (lane >> 3) + 8 * j; const LAS float* s = scr + (8 * c) * 33 + n;
        u32x4 o; o.x = cvt_pk_bf16(s[0 * 33], s[1 * 33]); o.y = cvt_pk_bf16(s[2 * 33], s[3 * 33]); o.z = cvt_pk_bf16(s[4 * 33], s[5 * 33]); o.w = cvt_pk_bf16(s[6 * 33], s[7 * 33]);
        *(u32x4*)(WT + (size_t)(drow0 + n) * D + k0 + 8 * c) = o; }
    LDS_WAIT(); asm volatile("" ::: "memory");
}
struct TrSrc { const float* W; unsigned char* WT; int ldw, k0, scol0, drow0; float cs; };
__device__ __forceinline__ void tr_load(const TrSrc& t, f32x4 (&v)[8], int lane) {
    const int kr = lane >> 3, nc = lane & 7;
#pragma unroll
    for (int it = 0; it < 8; ++it) v[it] = __builtin_nontemporal_load((const f32x4*)(t.W + (size_t)(t.k0 + 8 * it + kr) * t.ldw + t.scol0 + 4 * nc));
}
__device__ __forceinline__ void tr_store_f8(const TrSrc& t, const f32x4 (&v)[8], LAS float* scr, int lane) {
    const int kr = lane >> 3, nc = lane & 7;
#pragma unroll
    for (int it = 0; it < 8; ++it) { const int kk = 8 * it + kr; LAS float* sp = scr + kk * 33 + 4 * nc; sp[0] = v[it][0]; sp[1] = v[it][1]; sp[2] = v[it][2]; sp[3] = v[it][3]; }
    LDS_WAIT(); asm volatile("" ::: "memory");
    const int c = lane & 7; const float cs = t.cs;
#pragma unroll
    for (int j = 0; j < 4; ++j) { const int n = (lane >> 3) + 8 * j; const LAS float* sp = scr + (8 * c) * 33 + n;
        const f32x4 a = (f32x4){sp[0 * 33], sp[1 * 33], sp[2 * 33], sp[3 * 33]} * cs, b = (f32x4){sp[4 * 33], sp[5 * 33], sp[6 * 33], sp[7 * 33]} * cs;
        u32x2 o; o.x = pack4_fp8(a[0], a[1], a[2], a[3]); o.y = pack4_fp8(b[0], b[1], b[2], b[3]);
        *(u32x2*)(t.WT + (size_t)(t.drow0 + n) * D + t.k0 + 8 * c) = o; }
    LDS_WAIT(); asm volatile("" ::: "memory");
}
__device__ __forceinline__ void tr_item_f8(const float* W, int ldw, int k0, int scol0, unsigned char* WT, int drow0, float cs, LAS float* scr, int lane) {
    TrSrc t{W, WT, ldw, k0, scol0, drow0, cs}; f32x4 v[8]; tr_load(t, v, lane); tr_store_f8(t, v, scr, lane);
}
__device__ __forceinline__ int win_src_col(int np) {
    const int pn = np >> 8, j = np & 255;
    if (pn < 8) { const int ch = 128 * pn + (j & 127); return (j < 128) ? ch : 1024 + ch; }
    if (pn < 13) return np;
    const int ch = 128 * (pn - 13) + (j & 127); return (j < 128) ? 3328 + ch : 4352 + ch;
}

__device__ __forceinline__ float win_col_scale(int np) {
    const int pn = np >> 8, j = np & 255;
    if (pn < 8) return (j < 128) ? 1.f : LOG2E;
    if (pn < 12) return QSCALE;
    if (pn == 12) return 1.f;
    return LOG2E;
}

__device__ __forceinline__ void p0_prologue(const Args& args, LAS unsigned char* lds, int vcu, int G, int wave, int lane) {
    unsigned char* ws = args.ws;
    LAS float* scr = (LAS float*)(lds + wave * 16384);
    const int gw = vcu * 8 + wave, NGW = G * 8;
    {
        const float* x = args.in[I_X]; unsigned char* XF8 = ws + WS_R2;
        f32x4 gm[4];
#pragma unroll
        for (int j = 0; j < 4; ++j) gm[j] = *((const f32x4*)args.in[I_GMIX] + lane + 64 * j);
        for (int m0 = gw; m0 < M; m0 += 4 * NGW) {
            f32x4 v[4][4];
#pragma unroll
            for (int q = 0; q < 4; ++q) { const int m = m0 + q * NGW; if (m < M) { const f32x4* xr = (const f32x4*)(x + (size_t)m * D) + lane;
#pragma unroll
                for (int j = 0; j < 4; ++j) v[q][j] = __builtin_nontemporal_load(xr + 64 * j); } }
#pragma unroll
            for (int q = 0; q < 4; ++q) { const int m = m0 + q * NGW; if (m < M) {
                float s = 0.f;
#pragma unroll
                for (int j = 0; j < 4; ++j) s += (v[q][j][0] * v[q][j][0] + v[q][j][1] * v[q][j][1]) + (v[q][j][2] * v[q][j][2] + v[q][j][3] * v[q][j][3]);
                s = wave_sum(s);
                unsigned* o = (unsigned*)(XF8 + (size_t)m * D) + lane;
                const float rs = 1.0f / sqrtf(s * (1.f / D) + EPS);
#pragma unroll
                for (int j = 0; j < 4; ++j) { const f32x4 t = v[q][j] * rs * gm[j]; o[64 * j] = pack4_fp8(t[0], t[1], t[2], t[3]); } } }
        }
    }
    {
        constexpr int I_IN = 16 * (NIN / 32), I_SQ = 16 * 32, NITEMS = I_IN + 3 * I_SQ;
        for (int it = gw; it < NITEMS; it += NGW) {
            int r = it;
            if (r < I_IN) { const int kb = r / (NIN / 32), db = r % (NIN / 32); tr_item_f8(args.in[I_WIN], NIN, 64 * kb, win_src_col(32 * db), ws + WS_WIN, 32 * db, W8SCALE * win_col_scale(32 * db), scr, lane); continue; }
            r -= I_IN;
            const int which = r / I_SQ; r -= which * I_SQ; const int kb = r / 32, db = r % 32;
            const float* W = which == 0 ? args.in[I_WCO] : which == 1 ? args.in[I_WAO] : args.in[I_WOUT];
            bf16_t* WT = (bf16_t*)(ws + (which == 0 ? WS_WCO : which == 1 ? WS_WAO : WS_WO));
            tr_item(W, D, 64 * kb, 32 * db, nullptr, WT, 32 * db, scr, lane);
        }
    }
    {
        const int gt = (vcu * 8 + wave) * 64 + lane, NT_ = G * 512;
        float* bperm = (float*)(ws + WS_BPERM); const float* b_in = args.in[I_BIN];
        for (int i = gt; i < NIN; i += NT_) bperm[i] = b_in[win_src_col(i)] * win_col_scale(i);
        { bf16_t* wrt = (bf16_t*)(ws + WS_WRT); const float* wr = args.in[I_WR]; const float* gf = args.in[I_GFFN];
          for (int i = gt; i < D * NE; i += NT_) { const int k = i >> 5, e = i & 31; wrt[e * D + k] = (bf16_t)(cvt_pk_bf16(wr[i] * gf[k], 0.f) & 0xffffu); } }
        int* list = (int*)(ws + WS_LIST);
        for (int i = gt; i < NE * LIST_CAP / 4; i += NT_) ((int4*)list)[i] = make_int4(-1, -1, -1, -1);
    }
}
__device__ __forceinline__ TrSrc expert_half(const Args& args, int q, int h) {
    constexpr int P_GU = 8 * 64, PER_E = P_GU + 8 * 32;
    unsigned char* ws = args.ws;
    const int e = q / PER_E; int r = q % PER_E; TrSrc t;
    if (r < P_GU) { const int kp = r / 64, db = r % 64, np = 32 * db, pn = np >> 8, j = np & 255, ch = 128 * pn + (j & 127);
        t.W = ((j < 128) ? args.in[I_WG] : args.in[I_WU]) + (size_t)e * D * D; t.cs = (j < 128) ? W8SCALE * CGATE : W8SCALE; t.WT = ws + WS_WGU + (size_t)e * 2048 * D; t.ldw = D; t.k0 = 128 * kp + 64 * h; t.scol0 = ch; t.drow0 = np; }
    else { r -= P_GU; const int kp = r / 32, db = r % 32;
        t.W = args.in[I_WD] + (size_t)e * D * D; t.cs = W8SCALE; t.WT = ws + WS_WD + (size_t)e * D * D; t.ldw = D; t.k0 = 128 * kp + 64 * h; t.scol0 = 32 * db; t.drow0 = 32 * db; }
    return t;
}
__device__ __forceinline__ void tr_stage_f8(const TrSrc& t, const f32x4 (&v)[8], LAS float* scr, LAS unsigned char* img, int h, int lane) {
    const int kr = lane >> 3, nc = lane & 7;
#pragma unroll
    for (int it = 0; it < 8; ++it) { const int kk = 8 * it + kr; LAS float* sp = scr + kk * 33 + 4 * nc; sp[0] = v[it][0]; sp[1] = v[it][1]; sp[2] = v[it][2]; sp[3] = v[it][3]; }
    LDS_WAIT(); asm volatile("" ::: "memory");
    const int c = lane & 7; const float cs = t.cs;
#pragma unroll
    for (int j = 0; j < 4; ++j) { const int n = (lane >> 3) + 8 * j; const LAS float* sp = scr + (8 * c) * 33 + n;
        const f32x4 a = (f32x4){sp[0 * 33], sp[1 * 33], sp[2 * 33], sp[3 * 33]} * cs, b = (f32x4){sp[4 * 33], sp[5 * 33], sp[6 * 33], sp[7 * 33]} * cs;
        u32x2 o; o.x = pack4_fp8(a[0], a[1], a[2], a[3]); o.y = pack4_fp8(b[0], b[1], b[2], b[3]);
        *(LAS u32x2*)(img + n * 128 + h * 64 + 8 * c) = o; }
    LDS_WAIT(); asm volatile("" ::: "memory");
}
__device__ __forceinline__ void pair_flush(const TrSrc& t, const LAS unsigned char* img, int lane) {
#pragma unroll
    for (int j = 0; j < 4; ++j) { const int n = (lane >> 3) + 8 * j, pc = lane & 7;
        const u32x4 v = *(const LAS u32x4*)(img + n * 128 + 16 * pc);
        __builtin_nontemporal_store(v, (u32x4*)(t.WT + (size_t)(t.drow0 + n) * D + t.k0 + 16 * pc)); }
    LDS_WAIT(); asm volatile("" ::: "memory");
}
constexpr int CV_E0 = 4, CV_E1 = 8;
constexpr int CV_POOL0 = CV_E0 * 512, CV_POOL1 = CV_E1 * 256, CV_POOL2 = NE * 768 - CV_POOL0 - CV_POOL1;
__device__ __forceinline__ int pool_pair(int pool, int i) {
    if (pool == 0) return (i >> 9) * 768 + (i & 511);
    if (pool == 1) return (i >> 8) * 768 + 512 + (i & 255);
    if (i < (NE - CV_E0) * 512) return (CV_E0 + (i >> 9)) * 768 + (i & 511);
    i -= (NE - CV_E0) * 512; return (CV_E1 + (i >> 8)) * 768 + 512 + (i & 255);
}
struct NoPre { __device__ __forceinline__ void operator()() const {} };
template <class Pre = NoPre> __device__ __forceinline__ void p5_expert_weights(const Args& args, LAS unsigned char* lds, int pool, int gw, int NGW, int NPAIRS, int wave, int lane, Pre pre = Pre()) {
    LAS float* scr = (LAS float*)(lds + wave * 16384); LAS unsigned char* img = lds + wave * 16384 + 8448;
    const int mine = (gw < NPAIRS) ? (NPAIRS - gw + NGW - 1) / NGW : 0;
    const int ncpl = mine / 2;
    f32x4 va[8], vb[8], vc[8], vd[8];
    TrSrc ta, tb, tc, td;
    int it = gw;
    if (ncpl > 0) {
        ta = expert_half(args, pool_pair(pool, it), 0); tr_load(ta, va, lane); tb = expert_half(args, pool_pair(pool, it), 1); tr_load(tb, vb, lane);
        tc = expert_half(args, pool_pair(pool, it + NGW), 0); tr_load(tc, vc, lane); td = expert_half(args, pool_pair(pool, it + NGW), 1); tr_load(td, vd, lane);
    }
    pre();
    if (ncpl > 0) {
#pragma unroll 1
        for (int q = 0; q + 1 < ncpl; ++q) {
            it += 2 * NGW;
            { const TrSrc f = ta; tr_stage_f8(ta, va, scr, img, 0, lane); ta = expert_half(args, pool_pair(pool, it), 0); tr_load(ta, va, lane);
              tr_stage_f8(tb, vb, scr, img, 1, lane); tb = expert_half(args, pool_pair(pool, it), 1); tr_load(tb, vb, lane); pair_flush(f, img, lane); }
            { const TrSrc f = tc; tr_stage_f8(tc, vc, scr, img, 0, lane); tc = expert_half(args, pool_pair(pool, it + NGW), 0); tr_load(tc, vc, lane);
              tr_stage_f8(td, vd, scr, img, 1, lane); td = expert_half(args, pool_pair(pool, it + NGW), 1); tr_load(td, vd, lane); pair_flush(f, img, lane); }
        }
        tr_stage_f8(ta, va, scr, img, 0, lane); tr_stage_f8(tb, vb, scr, img, 1, lane); pair_flush(ta, img, lane);
        tr_stage_f8(tc, vc, scr, img, 0, lane); tr_stage_f8(td, vd, scr, img, 1, lane); pair_flush(tc, img, lane);
        it += 2 * NGW;
    }
    if (mine & 1) {
        ta = expert_half(args, pool_pair(pool, it), 0); tr_load(ta, va, lane); tb = expert_half(args, pool_pair(pool, it), 1); tr_load(tb, vb, lane);
        tr_stage_f8(ta, va, scr, img, 0, lane); tr_stage_f8(tb, vb, scr, img, 1, lane); pair_flush(ta, img, lane);
    }
}

template <class Pre = NoPre> __device__ __forceinline__ void conv_phase(const Args& args, LAS unsigned char* lds, int vcu, int G, int tid, int wave, int lane, Pre pre = Pre()) {
    unsigned char* ws = args.ws;
    const unsigned* U32 = (const unsigned*)(ws + WS_U); bf16_t* C = (bf16_t*)(ws + WS_R2);
    const float* cw = args.in[I_CONVW]; const float* cb = args.in[I_CONVB]; const float* lng = args.in[I_LNG]; const float* lnb = args.in[I_LNB];
    LAS float* T = (LAS float*)lds;
    f32x2 w[KCONV];
#pragma unroll
    for (int j = 0; j < KCONV; ++j) w[j] = *(const f32x2*)(cw + j * D + 2 * tid);
    const f32x2 cbv = *(const f32x2*)(cb + 2 * tid);
    LAS f32x4* lgb = (LAS f32x4*)(lds + MISC_OFF + MISC_IDX);
    if (tid < 256) { lgb[tid] = ((const f32x4*)lng)[tid]; lgb[256 + tid] = ((const f32x4*)lnb)[tid]; }
    pre();
    unsigned raw[62];
#define CONV_LOAD(unx) do { const int b_ = (unx) / (SEQ / 32), t0_ = ((unx) % (SEQ / 32)) * 32; const size_t rb_ = (size_t)b_ * SEQ; \
        _Pragma("unroll") for (int s = 0; s < 62; ++s) { const int ts = t0_ - 30 + s; const unsigned v_ = __builtin_nontemporal_load(U32 + (rb_ + (size_t)(ts < 0 ? 0 : ts)) * (D / 2) + tid); raw[s] = (ts >= 0) ? v_ : 0u; } } while (0)
    if (vcu < BATCH * (SEQ / 32)) CONV_LOAD(vcu);
    for (int un = vcu; un < BATCH * (SEQ / 32); un += G) {
        const int b = un / (SEQ / 32), t0 = (un % (SEQ / 32)) * 32;
        const size_t rowbase = (size_t)b * SEQ;
        f32x2 in[62];
#pragma unroll
        for (int s = 0; s < 62; ++s) in[s] = (f32x2){bf_lo(raw[s]), bf_hi(raw[s])};
#define CONV_O(o) { f32x2 a_ = cbv; _Pragma("unroll") for (int j = 0; j < KCONV; ++j) a_ = w[j] * in[(o) + j] + a_; *(LAS f32x2*)(T + (o) * D + 2 * tid) = a_; }
        CONV_O(0) CONV_O(1) CONV_O(2) CONV_O(3) CONV_O(4) CONV_O(5) CONV_O(6) CONV_O(7) CONV_O(8) CONV_O(9) CONV_O(10) CONV_O(11) CONV_O(12) CONV_O(13) CONV_O(14) CONV_O(15)
        CONV_O(16) CONV_O(17) CONV_O(18) CONV_O(19) CONV_O(20) CONV_O(21) CONV_O(22) CONV_O(23) CONV_O(24) CONV_O(25) CONV_O(26) CONV_O(27) CONV_O(28) CONV_O(29) CONV_O(30) CONV_O(31)
#undef CONV_O
        if (un + G < BATCH * (SEQ / 32)) CONV_LOAD(un + G);
        LDS_WAIT(); __builtin_amdgcn_s_barrier(); asm volatile("" ::: "memory");
#pragma unroll 2
        for (int i = 0; i < 4; ++i) {
            const int o = 4 * wave + i;
            f32x4 v[4]; float s = 0.f;
#pragma unroll
            for (int c = 0; c < 4; ++c) { v[c] = *(const LAS f32x4*)(T + o * D + 256 * c + 4 * lane); s += (v[c][0] + v[c][1]) + (v[c][2] + v[c][3]); }
            const float mean = wave_sum(s) * (1.f / D); float q = 0.f;
#pragma unroll
            for (int c = 0; c < 4; ++c) { v[c] = v[c] - mean; q += (v[c][0] * v[c][0] + v[c][1] * v[c][1]) + (v[c][2] * v[c][2] + v[c][3] * v[c][3]); }
            const float rstd = 1.0f / sqrtf(wave_sum(q) * (1.f / D) + EPS);
            u32x2* op = (u32x2*)(C + (rowbase + t0 + o) * D) + lane;
#pragma unroll
            for (int c = 0; c < 4; ++c) {
                f32x4 y = v[c] * rstd * lgb[64 * c + lane] + lgb[256 + 64 * c + lane];
#pragma unroll
                for (int j = 0; j < 4; ++j) y[j] = y[j] * sigmoid_f(y[j]);
                u32x2 pk; pk.x = cvt_pk_bf16(y[0], y[1]); pk.y = cvt_pk_bf16(y[2], y[3]); op[64 * c] = pk;
            }
        }
        LDS_WAIT(); __builtin_amdgcn_s_barrier(); asm volatile("" ::: "memory");
    }
}

#undef CONV_LOAD
constexpr int AT_K = 0, AT_V = 32768, AT_OST = 65536;
__device__ __forceinline__ int crow(int r, int hi) { return (r & 3) + 8 * (r >> 2) + 4 * hi; }
__device__ __forceinline__ s16x4 vtr(const LAS unsigned char* p) { typedef short v4i16_t __attribute__((ext_vector_type(4))); return __builtin_bit_cast(s16x4, __builtin_amdgcn_ds_read_tr16_b64_v4i16((LAS v4i16_t*)p)); }
__device__ __forceinline__ void attn_phase(const Args& args, LAS unsigned char* lds, int vcu, int G, int wave, int lane) {
    unsigned char* ws = args.ws;
    const bf16_t* KV = (const bf16_t*)(ws + WS_KV); bf16_t* QO = (bf16_t*)(ws + WS_QO);
    const int r32 = lane & 31, hi = lane >> 5;
    const LAS unsigned char* kbase = lds + AT_K + hi * 1024 + r32 * 16;
    const LAS unsigned char* vbase = lds + AT_V + ((lane >> 4) & 1) * 32 + (lane & 3) * 8 + (4 * hi + ((lane & 15) >> 2)) * 64;
    LAS bf16_t* stg = (LAS bf16_t*)(lds + AT_OST + wave * 4096);
    const int dq = r32 - 4 * hi;
    for (int un = vcu; un < BATCH * 2 * (SEQ / 128); un += G) {
        const int qb = un % (SEQ / 128), kvh = (un / (SEQ / 128)) & 1, b = un / (2 * (SEQ / 128));
        const int h = kvh * 8 + wave;
        const long T0 = (long)b * SEQ + 128 * qb;
#pragma unroll
        for (int t = 0; t < 4; ++t) {
            if (qb > 0 || t >= 2) {
                const long tok0 = T0 - 128 + 64 * t;
                const bf16_t* ks = KV + (size_t)(tok0 + lane) * 256 + kvh * 64 + wave * 8;
                const bf16_t* vs = KV + (size_t)(tok0 + 16 * (wave & 3) + (lane >> 2)) * 256 + 128 + kvh * 64 + (wave >> 2) * 32 + (lane & 3) * 8;
                __builtin_amdgcn_global_load_lds((const unsigned*)ks, (LAS unsigned*)(lds + AT_K + t * 8192 + wave * 1024), 16, 0, 0);
                __builtin_amdgcn_global_load_lds((const unsigned*)vs, (LAS unsigned*)(lds + AT_V + t * 8192 + wave * 1024), 16, 0, 0);
            }
        }
        const float slope2 = fast_exp2(-0.5f * (float)(h + 1)) * LOG2E;
        const float sink2 = args.in[I_SINKS][h] * LOG2E;
        f32x16 bias0;
#pragma unroll
        for (int r = 0; r < 16; ++r) bias0[r] = -slope2 * (float)(r32 - crow(r, hi));
        float drel[5];
#pragma unroll
        for (int rel = 0; rel < 5; ++rel) drel[rel] = fast_exp2(-32.f * (float)(4 - rel) * slope2);
        asm volatile("s_waitcnt vmcnt(0)" ::: "memory"); __builtin_amdgcn_s_barrier(); asm volatile("" ::: "memory");
#pragma unroll 1
        for (int qs = 0; qs < 4; ++qs) {
            const bf16_t* Qw = QO + (size_t)(T0 + 32 * qs + r32) * D + h * 64 + hi * 8;
            bf16x8 qr[4];
#pragma unroll
            for (int d0 = 0; d0 < 4; ++d0) qr[d0] = __builtin_nontemporal_load((const bf16x8*)(Qw + d0 * 16));
            f32x16 S[5];
#pragma unroll
            for (int rel = 0; rel < 5; ++rel) {
                const int blk = qs + rel;
                const bool valid = (qb > 0) || (blk >= 4);
                if (valid) {
                    S[rel] = bias0;
                    const LAS unsigned char* kp = kbase + (blk >> 1) * 8192 + (blk & 1) * 512;
#pragma unroll
                    for (int d0 = 0; d0 < 4; ++d0) { const bf16x8 kf = *(const LAS bf16x8*)(kp + d0 * 2048); S[rel] = __builtin_amdgcn_mfma_f32_32x32x16_bf16(kf, qr[d0], S[rel], 0, 0, 0); }
                } else {
#pragma unroll
                    for (int r = 0; r < 16; ++r) S[rel][r] = -INFINITY;
                }
            }
#pragma unroll
            for (int r = 0; r < 16; ++r) { const int rc = (r & 3) + 8 * (r >> 2); if (!(rc > dq)) S[0][r] = -INFINITY; if (!(rc <= dq)) S[4][r] = -INFINITY; }
            float l = 0.f;
#pragma unroll
            for (int rel = 0; rel < 5; ++rel) { float ls = 0.f;
#pragma unroll
                for (int r = 0; r < 16; ++r) { const float p = fast_exp2(S[rel][r]); S[rel][r] = p; ls += p; }
                l += ls * drel[rel]; }
            l += __shfl_xor(l, 32);
            l += fast_exp2(sink2);
            const float inv0 = 1.0f / l;
            f32x16 o[2];
#pragma unroll
            for (int r = 0; r < 16; ++r) { o[0][r] = 0.f; o[1][r] = 0.f; }
#pragma unroll
            for (int rel = 0; rel < 5; ++rel) {
                const int blk = qs + rel;
                const bool valid = (qb > 0) || (blk >= 4);
                if (valid) {
                    const LAS unsigned char* vp = vbase + (blk >> 1) * 8192 + (blk & 1) * 2048;
                    const float inv = inv0 * drel[rel];
#pragma unroll
                    for (int s = 0; s < 2; ++s) {
                        u32x4 pw;
                        pw.x = cvt_pk_bf16(S[rel][8 * s + 0] * inv, S[rel][8 * s + 1] * inv); pw.y = cvt_pk_bf16(S[rel][8 * s + 2] * inv, S[rel][8 * s + 3] * inv);
                        pw.z = cvt_pk_bf16(S[rel][8 * s + 4] * inv, S[rel][8 * s + 5] * inv); pw.w = cvt_pk_bf16(S[rel][8 * s + 6] * inv, S[rel][8 * s + 7] * inv);
                        const bf16x8 pa = __builtin_bit_cast(bf16x8, pw);
#pragma unroll
                        for (int d0 = 0; d0 < 2; ++d0) {
                            const s16x4 lo = vtr(vp + d0 * 4096 + s * 1024), hh = vtr(vp + d0 * 4096 + s * 1024 + 512);
                            const bf16x8 vf = (bf16x8){lo[0], lo[1], lo[2], lo[3], hh[0], hh[1], hh[2], hh[3]};
                            o[d0] = __builtin_amdgcn_mfma_f32_32x32x16_bf16(pa, vf, o[d0], 0, 0, 0);
                        }
                    }
                }
            }
#pragma unroll
            for (int r = 0; r < 16; ++r) { const int orow = crow(r, hi);
#pragma unroll
                for (int d0 = 0; d0 < 2; ++d0) stg[orow * 64 + d0 * 32 + r32] = (bf16_t)(cvt_pk_bf16(o[d0][r], 0.f) & 0xffffu); }
            LDS_WAIT(); asm volatile("" ::: "memory");
            bf16_t* Ow = QO + (size_t)(T0 + 32 * qs) * D + h * 64;
#pragma unroll
            for (int i = 0; i < 4; ++i) { const int row = i * 8 + (lane >> 3), ch = lane & 7; const u32x4 v = *(const LAS u32x4*)(stg + row * 64 + ch * 8); *(u32x4*)(Ow + (size_t)row * D + ch * 8) = v; }
            LDS_WAIT(); asm volatile("" ::: "memory");
        }
        LDS_WAIT(); __builtin_amdgcn_s_barrier(); asm volatile("" ::: "memory");
    }
}

__device__ __forceinline__ unsigned okey(float v, int idx) { unsigned u = __float_as_uint(v); u = (u & 0x80000000u) ? ~u : (u | 0x80000000u); return (u & ~31u) | (unsigned)(31 - idx); }
__device__ __forceinline__ float okey_val(unsigned k) { unsigned u = k & ~31u; u = (u & 0x80000000u) ? (u & 0x7fffffffu) : ~u; return __uint_as_float(u); }
__device__ __forceinline__ void router_preload(const Args& args, LAS unsigned char* lds, int tid) {
    constexpr int WROW = 2064;
    const u32x4* src = (const u32x4*)(args.ws + WS_WRT);
    for (int idx = tid; idx < NE * D * 2 / 16; idx += 512) { const int e = idx >> 7, c = idx & 127; *(LAS u32x4*)(lds + e * WROW + c * 16) = src[idx]; }
    for (int idx = tid; idx < D / 4; idx += 512) ((LAS f32x4*)(lds + MISC_OFF + MISC_IDX))[idx] = ((const f32x4*)args.in[I_GFFN])[idx];
}
__device__ __forceinline__ void router_phase(const Args& args, LAS unsigned char* lds, int vcu, int G, int tid, int wave, int lane) {
    unsigned char* ws = args.ws;
    const bf16_t* X1B = (const bf16_t*)(ws + WS_R2); unsigned char* X1F8 = ws + WS_X1F8;
    float* tokw = (float*)(ws + WS_TOKW); int* list = (int*)(ws + WS_LIST);
    gu32* gcnt = (gu32*)(ws + WS_CTL) + CW_GCNT;
    constexpr int WROW = 2064;
    LAS int* hist = (LAS int*)(lds + MISC_OFF + MISC_HIST); LAS int* sbase = (LAS int*)(lds + MISC_OFF + MISC_SBASE);
    LAS int* etab = (LAS int*)(lds + MISC_OFF + MISC_ETAB); LAS int* ltab = (LAS int*)(lds + MISC_OFF + MISC_LTAB);
    if (N_LAUNCHES != 1) router_preload(args, lds, tid);
    const int ce = lane & 15, kg = lane >> 4;
    const float br0 = args.in[I_BR][ce], br1 = args.in[I_BR][16 + ce];
    for (int grp = vcu; grp < M / 128; grp += G) {
        if (tid < NE) hist[tid] = 0;
        LDS_WAIT(); __builtin_amdgcn_s_barrier(); asm volatile("" ::: "memory");
        const int tokb = grp * 128 + wave * 16, tokA = tokb + ce;
        f32x4 acc0 = (f32x4){0.f, 0.f, 0.f, 0.f}, acc1 = (f32x4){0.f, 0.f, 0.f, 0.f}; float ss = 0.f;
        const LAS unsigned char* wp = lds + ce * WROW + kg * 16;
        const bf16_t* xrow = X1B + (size_t)tokA * D + 8 * kg;
#pragma unroll 1
        for (int c = 0; c < 4; ++c) {
            u32x4 a[8];
#pragma unroll
            for (int i = 0; i < 8; ++i) a[i] = *(const u32x4*)(xrow + 32 * (8 * c + i));
#pragma unroll
            for (int i = 0; i < 8; ++i) {
                const int ks = 8 * c + i;
                const bf16x8 b0 = *(const LAS bf16x8*)(wp + ks * 64), b1 = *(const LAS bf16x8*)(wp + 16 * WROW + ks * 64);
                const bf16x8 av = __builtin_bit_cast(bf16x8, a[i]);
                acc0 = __builtin_amdgcn_mfma_f32_16x16x32_bf16(av, b0, acc0, 0, 0, 0);
                acc1 = __builtin_amdgcn_mfma_f32_16x16x32_bf16(av, b1, acc1, 0, 0, 0);
#pragma unroll
                for (int q = 0; q < 4; ++q) { const float lo = bf_lo(a[i][q]), hi = bf_hi(a[i][q]); ss += lo * lo + hi * hi; }
            }
        }
        ss += __shfl_xor(ss, 16); ss += __shfl_xor(ss, 32);
        const float rs = 1.0f / sqrtf(ss * (1.f / D) + EPS);
#pragma unroll 1
        for (int c = 0; c < 4; ++c) {
            u32x4 a[8];
#pragma unroll
            for (int i = 0; i < 8; ++i) a[i] = __builtin_nontemporal_load((const u32x4*)(xrow + 32 * (8 * c + i)));
#pragma unroll
            for (int i = 0; i < 8; ++i) {
                u32x2 pk;
                const LAS f32x4* gl = (const LAS f32x4*)(lds + MISC_OFF + MISC_IDX) + (32 * (8 * c + i) + 8 * kg) / 4;
                const f32x4 g0 = gl[0] * rs, g1 = gl[1] * rs;
                pk.x = pack4_fp8(bf_lo(a[i][0]) * g0[0], bf_hi(a[i][0]) * g0[1], bf_lo(a[i][1]) * g0[2], bf_hi(a[i][1]) * g0[3]);
                pk.y = pack4_fp8(bf_lo(a[i][2]) * g1[0], bf_hi(a[i][2]) * g1[1], bf_lo(a[i][3]) * g1[2], bf_hi(a[i][3]) * g1[3]);
                *(u32x2*)(X1F8 + (size_t)tokA * D + 32 * (8 * c + i) + 8 * kg) = pk;
            }
        }
#pragma unroll
        for (int r = 0; r < 4; ++r) {
            const float rsr = __shfl(rs, 4 * kg + r);
            unsigned k0 = okey(acc0[r] * rsr + br0, ce), k1 = okey(acc1[r] * rsr + br1, 16 + ce);
            float tv[4]; int te[4];
#pragma unroll
            for (int k = 0; k < 4; ++k) {
                unsigned m = k0 > k1 ? k0 : k1;
#pragma unroll
                for (int o = 1; o < 16; o <<= 1) { const unsigned t = (unsigned)__shfl_xor((int)m, o); m = t > m ? t : m; }
                const int sel = 31 - (int)(m & 31u); te[k] = sel; tv[k] = okey_val(m);
                if (sel == ce) k0 = 0u; if (sel == 16 + ce) k1 = 0u;
            }
            const float e1 = __expf(tv[1] - tv[0]), e2 = __expf(tv[2] - tv[0]), e3 = __expf(tv[3] - tv[0]);
            const float inv = 1.0f / (1.0f + e1 + e2 + e3);
            if (ce < 4) {
                const int ek = ce == 0 ? te[0] : ce == 1 ? te[1] : ce == 2 ? te[2] : te[3];
                const float wk = (ce == 0 ? 1.0f : ce == 1 ? e1 : ce == 2 ? e2 : e3) * inv;
                const int tli = wave * 16 + 4 * kg + r;
                const int lp = __hip_atomic_fetch_add(hist + ek, 1, __ATOMIC_RELAXED, __HIP_MEMORY_SCOPE_WORKGROUP);
                etab[tli * 4 + ce] = ek; ltab[tli * 4 + ce] = lp;
                tokw[(size_t)(tokb + 4 * kg + r) * 4 + ce] = wk;
            }
        }
        LDS_WAIT(); __builtin_amdgcn_s_barrier(); asm volatile("" ::: "memory");
        if (tid < NE) sbase[tid] = (int)__hip_atomic_fetch_add(gcnt + tid, (unsigned)hist[tid], RLX_AGENT);
        LDS_WAIT(); __builtin_amdgcn_s_barrier(); asm volatile("" ::: "memory");
        { const int e = etab[tid], pos = sbase[e] + ltab[tid]; list[(size_t)e * LIST_CAP + pos] = ((grp * 128 + (tid >> 2)) << 2) | (tid & 3);
          ((int*)(ws + WS_ROWOF))[grp * 512 + tid] = (e << 16) | pos; }
        LDS_WAIT(); __builtin_amdgcn_s_barrier(); asm volatile("" ::: "memory");
    }
}

__device__ __forceinline__ void build_moe_table(const Args& args, LAS unsigned char* lds, int tid) {
    LAS int* tbl = (LAS int*)(lds + MISC_OFF + MISC_TBL);
    gu32* gcnt = (gu32*)(args.ws + WS_CTL) + CW_GCNT;
    if (tid < 64) {
        const int c = (tid < NE) ? (int)__hip_atomic_load(gcnt + (tid & 31), RLX_AGENT) : 0; const int nrt = (c + 255) >> 8; int inc = nrt;
#pragma unroll
        for (int o = 1; o < 32; o <<= 1) { const int t = __shfl_up(inc, o); if ((tid & 63) >= o) inc += t; }
        if (tid < NE) tbl[tid] = inc - nrt; if (tid == NE - 1) tbl[NE] = inc;
        int ci = c;
#pragma unroll
        for (int o = 1; o < 32; o <<= 1) { const int t = __shfl_up(ci, o); if ((tid & 63) >= o) ci += t; }
        if (tid < NE) ((LAS int*)(lds + MISC_OFF + MISC_CPRE))[tid] = ci - c; if (tid == NE - 1) ((LAS int*)(lds + MISC_OFF + MISC_CPRE))[NE] = ci;
    }
    LDS_WAIT(); __syncthreads();
}

template <class Pre> __device__ __forceinline__ void final_phase(const Args& args, LAS unsigned char* lds, int vcu, int G, int wave, int lane, Pre pre) {
    unsigned char* ws = args.ws;
    const bf16_t* X1B = (const bf16_t*)(ws + WS_R2); const float* tokw = (const float*)(ws + WS_TOKW); const float* gfin = args.in[I_GFIN];
    const unsigned char* Y = ws + WS_Y; const int* rowof = (const int*)(ws + WS_ROWOF);
    const int gw = vcu * 8 + wave, NGW = G * 8;
    f32x4 gv[4];
#pragma unroll
    for (int q = 0; q < 4; ++q) gv[q] = *(const f32x4*)(gfin + 16 * lane + 4 * q);
    int cp;
    { const int c = (lane < NE) ? (int)__hip_atomic_load((gu32*)(ws + WS_CTL) + CW_GCNT + (lane & 31), RLX_AGENT) : 0; int inc = c;
#pragma unroll
      for (int o = 1; o < 32; o <<= 1) { const int t = __shfl_up(inc, o); if (lane >= o) inc += t; }
      cp = inc - c; }
    int4 rw[2];
#pragma unroll
    for (int t = 0; t < 2; ++t) { const int tok = gw + t * NGW; rw[t] = (tok < M) ? *(const int4*)(rowof + (size_t)tok * 4) : make_int4(0, 0, 0, 0); }
    pre();
    for (int tok0 = gw; tok0 < M; tok0 += 2 * NGW) {
        f32x4 w[2]; u32x4 xa[2], xb[2], y[2][4];
#pragma unroll
        for (int t = 0; t < 2; ++t) { const int tok = tok0 + t * NGW; if (tok < M) {
            const int iw[4] = {__builtin_amdgcn_readfirstlane(rw[t].x), __builtin_amdgcn_readfirstlane(rw[t].y), __builtin_amdgcn_readfirstlane(rw[t].z), __builtin_amdgcn_readfirstlane(rw[t].w)};
            int rk[4];
#pragma unroll
            for (int k = 0; k < 4; ++k) rk[k] = __builtin_amdgcn_readlane(cp, iw[k] >> 16) + (iw[k] & 0xffff);
            w[t] = *(const f32x4*)(tokw + (size_t)tok * 4);
            xa[t] = __builtin_nontemporal_load((const u32x4*)(X1B + (size_t)tok * D + 16 * lane)); xb[t] = __builtin_nontemporal_load((const u32x4*)(X1B + (size_t)tok * D + 16 * lane + 8));
#pragma unroll
            for (int k = 0; k < 4; ++k) y[t][k] = __builtin_nontemporal_load((const u32x4*)(Y + (size_t)rk[k] * 1024 + 16 * lane)); } }
#pragma unroll
        for (int t = 0; t < 2; ++t) { const int tok = tok0 + 2 * NGW + t * NGW; rw[t] = (tok < M) ? *(const int4*)(rowof + (size_t)tok * 4) : make_int4(0, 0, 0, 0); }
#pragma unroll
        for (int t = 0; t < 2; ++t) { const int tok = tok0 + t * NGW; if (tok < M) {
            f32x4 v[4];
            v[0] = (f32x4){bf_lo(xa[t].x), bf_hi(xa[t].x), bf_lo(xa[t].y), bf_hi(xa[t].y)}; v[1] = (f32x4){bf_lo(xa[t].z), bf_hi(xa[t].z), bf_lo(xa[t].w), bf_hi(xa[t].w)};
            v[2] = (f32x4){bf_lo(xb[t].x), bf_hi(xb[t].x), bf_lo(xb[t].y), bf_hi(xb[t].y)}; v[3] = (f32x4){bf_lo(xb[t].z), bf_hi(xb[t].z), bf_lo(xb[t].w), bf_hi(xb[t].w)};
            float s = 0.f;
#pragma unroll
            for (int q = 0; q < 4; ++q) {
#pragma unroll
                for (int k = 0; k < 4; ++k) {
                    const int word = (int)y[t][k][q];
                    const f32x2 lo = __builtin_amdgcn_cvt_pk_f32_fp8(word, false), hi = __builtin_amdgcn_cvt_pk_f32_fp8(word, true);
                    v[q] += w[t][k] * (f32x4){lo[0], lo[1], hi[0], hi[1]};
                }
                s += (v[q][0] * v[q][0] + v[q][1] * v[q][1]) + (v[q][2] * v[q][2] + v[q][3] * v[q][3]);
            }
            const float rstd = 1.0f / sqrtf(wave_sum(s) * (1.f / D) + EPS);
            asm volatile("" ::: "memory");
#pragma unroll
            for (int q = 0; q < 4; ++q) v[q] = v[q] * rstd * gv[q];
            LAS unsigned char* sc = lds + wave * 8192 + t * 4096;
#pragma unroll
            for (int q = 0; q < 4; ++q) *(LAS f32x4*)(sc + 64 * lane + 16 * ((q + lane) & 3)) = v[q];
            asm volatile("s_waitcnt lgkmcnt(0)" ::: "memory");
#pragma unroll
            for (int q = 0; q < 4; ++q) { const int ls = (lane >> 2) + 16 * q, qs = lane & 3;
                const f32x4 o = *(const LAS f32x4*)(sc + 64 * ls + 16 * ((qs + ls) & 3));
                __builtin_nontemporal_store(o, (f32x4*)(args.out + (size_t)tok * D + 256 * q + 4 * lane)); }
            asm volatile("" ::: "memory"); } }
    }
}

__global__ void __launch_bounds__(512, 2) mk_fwd(Args args) {
    extern __shared__ __attribute__((aligned(16))) unsigned char lds_raw[];
    LAS unsigned char* lds = (LAS unsigned char*)lds_raw;
    const int tid = threadIdx.x, lane = tid & 63, wave = __builtin_amdgcn_readfirstlane(tid >> 6);
    const int G = gridDim.x; const int bx = blockIdx.x; const int vcu = (G % 8 == 0) ? (bx % 8) * (G / 8) + bx / 8 : bx;
    unsigned char* ws = args.ws;
    gu32* ctl = (gu32*)(ws + WS_CTL);
    if (tid < 4) ((LAS unsigned*)(lds + MISC_OFF + MISC_XB))[tid] = 0u;
    __syncthreads();
    XcdBarrier bar; bar.bar = (unsigned*)ctl + CW_BAR; bar.x = 0; bar.st = nullptr;
    if (N_LAUNCHES == 1) bar = xcd_barrier_post((unsigned*)ctl + CW_BAR, (volatile LAS unsigned*)(lds + MISC_OFF + MISC_XB));
    const int lo = args.ph_lo, hi = args.ph_hi;
#ifndef ONLY_PHASE
#define ONLY_PHASE -1
#endif
#define IN(k) ((ONLY_PHASE < 0 || (k) == ONLY_PHASE) && lo <= (k) && (k) < hi)
#define BOTH(k) (IN(k) && IN((k) + 1))
#ifndef REP_BAR
#define REP_BAR 1
#endif
#define GRID_BAR() do { xcd_barrier(bar); if (REP_BAR >= 2) { xcd_barrier(bar); xcd_barrier(bar); } } while (0)

    if (IN(0)) { for (int rep = 0; rep < REP_P0; ++rep) { p0_prologue(args, lds, vcu, G, wave, lane); __syncthreads(); } if (BOTH(0)) GRID_BAR(); }

    if (IN(1)) {
        mg::DenseSched<1024> S; S.so.init(M, NIN, G, bx); S.A = (const char*)(ws + WS_R2); S.Bt = (const char*)(ws + WS_WIN);
        mg::EpiIn E{(const float*)(ws + WS_BPERM), (bf16_t*)(ws + WS_U), (bf16_t*)(ws + WS_QO), (bf16_t*)(ws + WS_KV), (bf16_t*)(ws + WS_RR), (bf16_t*)(ws + WS_GA), 0};
        if (bx >= G / 2) { p5_expert_weights(args, lds, 0, (bx - G / 2) * 8 + wave, (G / 2) * 8, CV_POOL0, wave, lane); }
        __syncthreads();
        mg::gemm_phase<mg::EpiIn, mg::DenseSched<1024>>(lds, S, E);
        if (REP_P1 >= 2 && REP_NULL == 2) { mg::EpiInT<false> E2{E.bperm, E.U, E.Q, E.KV, E.RR, E.GA, args.li}; mg::gemm_phase<mg::EpiInT<false>, mg::DenseSched<1024>>(lds, S, E2); }
        else if (REP_P1 >= 2) { if (REP_NULL == 1) { mg::EpiNull<mg::EpiIn> EN{E}; mg::gemm_phase<mg::EpiNull<mg::EpiIn>, mg::DenseSched<1024>>(lds, S, EN); } else mg::gemm_phase<mg::EpiIn, mg::DenseSched<1024>>(lds, S, E); }
        if (BOTH(1) && N_LAUNCHES != 1) GRID_BAR();
    }

    if (IN(2)) {
        const bool conv_first = ((bx >> 3) & 1) != 0;
        auto bar12 = [&]() { if (N_LAUNCHES == 1) GRID_BAR(); };
        if (!conv_first) { p5_expert_weights(args, lds, 2, vcu * 8 + wave, G * 8, CV_POOL2, wave, lane, bar12); __syncthreads(); conv_phase(args, lds, vcu, G, tid, wave, lane); }
        else conv_phase(args, lds, vcu, G, tid, wave, lane, bar12);
        if (REP_CONV >= 2) { int t_ = threadIdx.x; asm volatile("" : "+v"(t_)); __syncthreads(); conv_phase(args, lds, vcu, G, t_, __builtin_amdgcn_readfirstlane(t_ >> 6), t_ & 63); }
        attn_phase(args, lds, vcu, G, wave, lane);
        if (conv_first) { __syncthreads(); p5_expert_weights(args, lds, 2, vcu * 8 + wave, G * 8, CV_POOL2, wave, lane); }
        if (BOTH(2)) GRID_BAR();
    }

    if (IN(3)) {
        mg::MixSched S; S.so.init(M, D, G, bx); S.A0 = (const char*)(ws + WS_R2); S.A1 = (const char*)(ws + WS_QO); S.B0 = (const char*)(ws + WS_WCO); S.B1 = (const char*)(ws + WS_WAO);
        mg::EpiMix E{(const bf16_t*)(ws + WS_RR), (const bf16_t*)(ws + WS_GA), args.in[I_BCO], args.in[I_BAO], (bf16_t*)(ws + WS_MIX)};
        mg::gemm_phase<mg::EpiMix, mg::MixSched>(lds, S, E);
        if (REP_P3 >= 2) { if (REP_NULL == 1) { mg::EpiNull<mg::EpiMix> EN{E}; mg::gemm_phase<mg::EpiNull<mg::EpiMix>, mg::MixSched>(lds, S, EN); } else mg::gemm_phase<mg::EpiMix, mg::MixSched>(lds, S, E); }
        if (BOTH(3)) GRID_BAR();
    }

    if (IN(4)) {
        mg::DenseSched<2048> S; S.so.init(M, D, G, bx); S.A = (const char*)(ws + WS_MIX); S.Bt = (const char*)(ws + WS_WO);
        mg::EpiRes E{args.in[I_X], (bf16_t*)(ws + WS_R2)};
        mg::gemm_phase<mg::EpiRes, mg::DenseSched<2048>>(lds, S, E);
        if (REP_P4 >= 2) { if (REP_NULL == 1) { mg::EpiNull<mg::EpiRes> EN{E}; mg::gemm_phase<mg::EpiNull<mg::EpiRes>, mg::DenseSched<2048>>(lds, S, EN); } else mg::gemm_phase<mg::EpiRes, mg::DenseSched<2048>>(lds, S, E); }
        if (N_LAUNCHES == 1) { int t_ = threadIdx.x; asm volatile("" : "+v"(t_)); router_preload(args, lds, t_); }
        if (BOTH(4)) GRID_BAR();
    }

    if (IN(5)) {
        router_phase(args, lds, vcu, G, tid, wave, lane);
        if (BOTH(5)) GRID_BAR();
    }

    if (IN(6)) {
        build_moe_table(args, lds, tid);
        {
            const int rem = (((const LAS int*)(lds + MISC_OFF + MISC_TBL))[NE] * 8) % G, ns = G - rem;
            if (rem > 0 && ns >= G / 4) { if (vcu >= rem) p5_expert_weights(args, lds, 1, (vcu - rem) * 8 + wave, ns * 8, CV_POOL1, wave, lane); }
            else p5_expert_weights(args, lds, 1, vcu * 8 + wave, G * 8, CV_POOL1, wave, lane);
            __syncthreads();
        }
        mg::MoeSched<8, true, 1024> S{(const LAS int*)(lds + MISC_OFF + MISC_TBL), vcu, G, (const char*)(ws + WS_X1F8), (const char*)(ws + WS_WGU), (const int*)(ws + WS_LIST)};
        S.preload(lds, tid);
        mg::EpiSwiglu E{args.in[I_BG], args.in[I_BU], ws + WS_ACT};
        mg::gemm_phase<mg::EpiSwiglu, mg::MoeSched<8, true, 1024>>(lds, S, E);
        if (REP_P6 >= 2) { if (REP_NULL == 1) { mg::EpiNull<mg::EpiSwiglu> EN{E}; mg::gemm_phase<mg::EpiNull<mg::EpiSwiglu>, mg::MoeSched<8, true, 1024>>(lds, S, EN); } else mg::gemm_phase<mg::EpiSwiglu, mg::MoeSched<8, true, 1024>>(lds, S, E); }
        if (BOTH(6)) GRID_BAR();
    }

    if (IN(7)) {
        if (N_LAUNCHES != 1) build_moe_table(args, lds, tid);
        mg::MoeSched<4, false, 1024> S{(const LAS int*)(lds + MISC_OFF + MISC_TBL), vcu, G, (const char*)(ws + WS_ACT), (const char*)(ws + WS_WD), (const int*)(ws + WS_LIST)};
        S.preload(lds, tid);
        mg::EpiDown E{(const LAS int*)(lds + MISC_OFF), args.in[I_BD], ws + WS_Y};
        mg::gemm_phase<mg::EpiDown, mg::MoeSched<4, false, 1024>>(lds, S, E);
        if (REP_P7 >= 2) { if (REP_NULL == 1) { mg::EpiNull<mg::EpiDown> EN{E}; mg::gemm_phase<mg::EpiNull<mg::EpiDown>, mg::MoeSched<4, false, 1024>>(lds, S, EN); } else mg::gemm_phase<mg::EpiDown, mg::MoeSched<4, false, 1024>>(lds, S, E); }
        if (BOTH(7) && N_LAUNCHES != 1) GRID_BAR();
    }

    if (IN(8)) { int t_ = threadIdx.x; asm volatile("" : "+v"(t_)); const int lane8 = t_ & 63, wave8 = __builtin_amdgcn_readfirstlane(t_ >> 6);
        final_phase(args, lds, vcu, G, wave8, lane8, [&]() { if (N_LAUNCHES == 1) GRID_BAR(); });
        if (REP_P8 >= 2) { __syncthreads(); final_phase(args, lds, vcu, G, wave8, lane8, []() {}); } }
#undef IN
#undef BOTH
#undef GRID_BAR
}

extern "C" void kernel_launch(void* const* d_in, const int* in_sizes, int n_in, void* d_out, int out_size, void* d_ws, size_t ws_size, hipStream_t stream) {
    static int grid = 0;
    if (grid == 0) {
        if (n_in != 24 || in_sizes[0] != M * D || out_size != M * D || ws_size < WS_END) { fprintf(stderr, "kernel_launch: unexpected shapes / workspace (%zu < %zu); nothing launched\n", ws_size, (size_t)WS_END); grid = -1; return; }
        int dev = 0, cus = 0, per_cu = 0;
        if (hipGetDevice(&dev) != hipSuccess || hipDeviceGetAttribute(&cus, hipDeviceAttributeMultiprocessorCount, dev) != hipSuccess) { grid = -1; return; }
        if (hipFuncSetAttribute((const void*)mk_fwd, hipFuncAttributeMaxDynamicSharedMemorySize, LDS_BYTES) != hipSuccess) { fprintf(stderr, "kernel_launch: hipFuncSetAttribute failed\n"); grid = -1; return; }
        if (hipOccupancyMaxActiveBlocksPerMultiprocessor(&per_cu, (const void*)mk_fwd, 512, LDS_BYTES) != hipSuccess || per_cu < 1) { fprintf(stderr, "kernel_launch: occupancy query says %d\n", per_cu); }
        (void)hipGetLastError();
        grid = cus;
    }
    if (grid < 0) return;
    if (hipMemsetAsync((char*)d_ws + WS_CTL, 0, CTL_ZERO_BYTES, stream) != hipSuccess) return;
    Args a{};
    for (int i = 0; i < 24; ++i) a.in[i] = (const float*)d_in[i];
    a.out = (float*)d_out; a.ws = (unsigned char*)d_ws;
    if (N_LAUNCHES == 1) {
        a.ph_lo = 0; a.ph_hi = N_PHASES; a.li = 0;
        hipLaunchKernelGGL(mk_fwd, dim3(grid), dim3(512), LDS_BYTES, stream, a);
    } else {
        for (int li = 0; li < N_PHASES; ++li) { a.ph_lo = li; a.ph_hi = li + 1; a.li = li; hipLaunchKernelGGL(mk_fwd, dim3(grid), dim3(512), LDS_BYTES, stream, a); }
    }
}
```

```cpp
#include <hip/hip_runtime.h>
#include <cstdio>
#include <cstdint>

#define LAS __attribute__((address_space(3)))
#define GAS __attribute__((address_space(1)))
typedef unsigned short bf16_t;
typedef short bf16x8 __attribute__((ext_vector_type(8)));
typedef short s16x4 __attribute__((ext_vector_type(4)));
typedef float f32x2 __attribute__((ext_vector_type(2)));
typedef float f32x4 __attribute__((ext_vector_type(4)));
typedef float f32x16 __attribute__((ext_vector_type(16)));
typedef unsigned u32x2 __attribute__((ext_vector_type(2)));
typedef unsigned u32x4 __attribute__((ext_vector_type(4)));
typedef GAS unsigned gu32;
typedef int i32x4 __attribute__((ext_vector_type(4)));
typedef int i32x8 __attribute__((ext_vector_type(8)));
constexpr float W8SCALE = 32.f;
constexpr int W8_MFMA_SCALE = 0x7a7a7a7a;
constexpr float CGATE = 1.702f * 1.4426950408889634f;

#ifndef MK_N_LAUNCHES
#define MK_N_LAUNCHES 1
#endif
#ifndef REP_EPI
#define REP_EPI 0
#endif
#ifndef REP_P0
#define REP_P0 1
#endif
#ifndef STAG_P1
#define STAG_P1 2
#endif
#ifndef REP_P8
#define REP_P8 1
#endif
#ifndef REP_CV
#define REP_CV 1
#endif
#ifndef REP_CONV
#define REP_CONV 1
#endif
#ifndef CVF_PAIRS
#define CVF_PAIRS 2
#endif
#ifndef STAG_P7
#define STAG_P7 2
#endif
#ifndef REP_NULL
#define REP_NULL 0
#endif
#ifndef REP_P1
#define REP_P1 1
#endif
#ifndef REP_CONV
#define REP_CONV 1
#endif
#ifndef REP_P3
#define REP_P3 1
#endif
#ifndef REP_P4
#define REP_P4 1
#endif
#ifndef REP_P5B
#define REP_P5B 1
#endif
#ifndef REP_P6
#define REP_P6 1
#endif
#ifndef REP_P7
#define REP_P7 1
#endif
constexpr int N_PHASES = 9;
constexpr int N_LAUNCHES = MK_N_LAUNCHES;

constexpr int BATCH = 8, SEQ = 4096, D = 1024, M = BATCH * SEQ, NIN = 5376, NE = 32, KCONV = 31;
constexpr float EPS = 1e-5f;
constexpr float LOG2E = 1.4426950408889634f;
constexpr float QSCALE = 0.125f * LOG2E;
constexpr int LIST_CAP = 32768;

constexpr size_t MiB = 1u << 20;
constexpr size_t WS_CTL = 0, CTL_ZERO_BYTES = 128 * 1024;
constexpr size_t WS_LIST = 1 * MiB;
constexpr size_t WS_TOKW = 5 * MiB;
constexpr size_t WS_RSTD1 = 5 * MiB + 512 * 1024;
constexpr size_t WS_RSTD2 = WS_RSTD1 + 128 * 1024;
constexpr size_t WS_BPERM = WS_RSTD2 + 128 * 1024;
constexpr size_t WS_WRT = 6 * MiB;
constexpr size_t WS_R1 = 7 * MiB;
constexpr size_t WS_U = WS_R1, WS_QO = WS_R1 + 64 * MiB, WS_KV = WS_R1 + 128 * MiB, WS_RR = WS_R1 + 144 * MiB, WS_GA = WS_R1 + 208 * MiB;
constexpr size_t WS_MIX = WS_U;
constexpr size_t WS_ACT = WS_R1;
constexpr size_t WS_X1F8 = WS_R1 + 136 * MiB;
constexpr size_t WS_Y = WS_R1 + 136 * MiB;
constexpr size_t WS_ROWOF = 6 * MiB + 256 * 1024;
constexpr size_t WS_R2 = 279 * MiB;
constexpr size_t WS_R4 = 343 * MiB;
constexpr size_t WS_WIN = 503 * MiB, WS_WCO = WS_WIN + 11 * MiB, WS_WAO = WS_WIN + 13 * MiB, WS_WO = WS_WIN + 15 * MiB;
constexpr size_t WS_WGU = WS_R4, WS_YB = WS_R4;
constexpr size_t WS_WD = 471 * MiB;
constexpr size_t WS_END = 535 * MiB;

constexpr int CW_BAR = 4096;
constexpr int CW_GCNT = 16384;

constexpr int RING_BYTES = 131072;
constexpr int MISC_OFF = RING_BYTES;
constexpr int MISC_XB = 0;
constexpr int MISC_CPRE = 64;
constexpr int MISC_TBL = 256;
constexpr int MISC_UTAB = 512;
constexpr int MISC_HIST = 512, MISC_SBASE = 640;
constexpr int MISC_ETAB = 1024, MISC_LTAB = 3072;
constexpr int MISC_IDX = 8192;
constexpr int IDX_SLOTS = 18;
constexpr int LDS_BYTES = RING_BYTES + 8192 + IDX_SLOTS * 1024;

#define RLX_AGENT __ATOMIC_RELAXED, __HIP_MEMORY_SCOPE_AGENT
#define LDS_WAIT() asm volatile("s_waitcnt lgkmcnt(0)" ::: "memory")
#define VM_WAIT() asm volatile("s_waitcnt vmcnt(0)" ::: "memory")
__device__ __forceinline__ unsigned cvt_pk_bf16(float lo, float hi) { unsigned r; asm volatile("v_cvt_pk_bf16_f32 %0, %1, %2" : "=v"(r) : "v"(lo), "v"(hi)); return r; }
__device__ __forceinline__ float bf_lo(unsigned w) { return __uint_as_float(w << 16); }
__device__ __forceinline__ float bf_hi(unsigned w) { return __uint_as_float(w & 0xffff0000u); }
__device__ __forceinline__ float fast_exp2(float x) { return __builtin_amdgcn_exp2f(x); }
__device__ __forceinline__ float fast_rcp(float x) { return __builtin_amdgcn_rcpf(x); }
__device__ __forceinline__ float sigmoid_f(float x) { return fast_rcp(1.f + fast_exp2(-LOG2E * x)); }
__device__ __forceinline__ float wave_sum(float v) {
#pragma unroll
    for (int o = 1; o < 64; o <<= 1) v += __shfl_xor(v, o);
    return v;
}
__device__ __forceinline__ float wave_max(float v) {
#pragma unroll
    for (int o = 1; o < 64; o <<= 1) v = fmaxf(v, __shfl_xor(v, o));
    return v;
}
__device__ __forceinline__ unsigned pack4_fp8(float a, float b, float c, float d) { int v = 0; v = __builtin_amdgcn_cvt_pk_fp8_f32(a, b, v, false); v = __builtin_amdgcn_cvt_pk_fp8_f32(c, d, v, true); return (unsigned)v; }
__device__ __forceinline__ u32x4 pack8(f32x4 a, f32x4 b) { u32x4 w; w.x = cvt_pk_bf16(a[0], a[1]); w.y = cvt_pk_bf16(a[2], a[3]); w.z = cvt_pk_bf16(b[0], b[1]); w.w = cvt_pk_bf16(b[2], b[3]); return w; }

#define XB_TMO      128
#define XB_XCNT(j)  (256  + 64 * (j))
#define XB_XSUB(j)  (1280 + 64 * (j))
#define XB_XGEN(j)  (2304 + 64 * (j))
#define XB_TOP      3328
#define XB_TOPGEN   3392
#define XCD_BAR_WORDS 3456
#define XB_SPIN_CAP (1u << 18)

__device__ __forceinline__ unsigned xb_ld(unsigned* p)              { return __hip_atomic_load(p, __ATOMIC_RELAXED, __HIP_MEMORY_SCOPE_AGENT); }
__device__ __forceinline__ unsigned xb_add(unsigned* p, unsigned v) { return __hip_atomic_fetch_add(p, v, __ATOMIC_RELAXED, __HIP_MEMORY_SCOPE_AGENT); }
__device__ __forceinline__ unsigned xb_xcc_id() { return (unsigned)__builtin_amdgcn_s_getreg((3 << 11) | 20) & 0xFu; }
#define XB_SPIN(cond, bar) do { unsigned _sp = 0; while (cond) { __builtin_amdgcn_s_sleep(1); \
    if ((++_sp & 255u) == 0u) { if (xb_ld(&(bar)[XB_TMO])) break; if (_sp > XB_SPIN_CAP) { atomicAdd(&(bar)[XB_TMO], 1u); break; } } } } while (0)

struct XcdBarrier { unsigned* bar; unsigned x; volatile LAS unsigned* st; };

__device__ __forceinline__ XcdBarrier xcd_barrier_post(unsigned* bar, volatile LAS unsigned* st) {
    XcdBarrier b; b.bar = bar; b.x = xb_xcc_id(); b.st = st;
    if (threadIdx.x == 0) (void)xb_add(&bar[XB_XCNT(b.x)], 1u);
    return b;
}
__device__ __forceinline__ void xcd_barrier_complete(unsigned* bar, unsigned x, unsigned& nloc, unsigned& nx) {
    const unsigned G = gridDim.x * gridDim.y * gridDim.z;
    unsigned sum, cnt, mine, sp = 0u;
    for (;;) {
        sum = 0u; cnt = 0u; mine = 0u;
#pragma unroll
        for (unsigned j = 0; j < 16; ++j) { const unsigned c = xb_ld(&bar[XB_XCNT(j)]); sum += c; cnt += (c > 0u) ? 1u : 0u; mine = (j == x) ? c : mine; }
        if (sum == G) break;
        __builtin_amdgcn_s_sleep(1);
        if ((++sp & 255u) == 0u) { if (xb_ld(&bar[XB_TMO])) break; if (sp > XB_SPIN_CAP) { atomicAdd(&bar[XB_TMO], 1u); break; } }
    }
    nloc = mine > 0u ? mine : 1u; nx = cnt > 0u ? cnt : 1u;
}
__device__ __forceinline__ void xcd_barrier(const XcdBarrier& b) {
    asm volatile("s_waitcnt vmcnt(0)" ::: "memory");
    __syncthreads();
    if (threadIdx.x == 0) {
        unsigned* bar = b.bar;
        __builtin_amdgcn_s_waitcnt(0);
        unsigned nloc = b.st[0], nx = b.st[1];
        if (nloc == 0u) { xcd_barrier_complete(bar, b.x, nloc, nx); b.st[0] = nloc; b.st[1] = nx; }
        const unsigned old = xb_add(&bar[XB_XSUB(b.x)], 1u);
        const unsigned gen = old / nloc;
        if (old + 1u == (gen + 1u) * nloc) {
            __builtin_amdgcn_fence(__ATOMIC_RELEASE, "agent");
            asm volatile("s_waitcnt vmcnt(0)" ::: "memory");
            const unsigned og = xb_add(&bar[XB_TOP], 1u);
            const unsigned tg = og / nx;
            if (og + 1u == (tg + 1u) * nx) xb_add(&bar[XB_TOPGEN], 1u);
            else XB_SPIN(xb_ld(&bar[XB_TOPGEN]) == tg, bar);
            __builtin_amdgcn_fence(__ATOMIC_ACQUIRE, "agent");
            xb_add(&bar[XB_XGEN(b.x)], 1u);
            asm volatile("s_waitcnt vmcnt(0)" ::: "memory");
        } else {
            XB_SPIN(xb_ld(&bar[XB_XGEN(b.x)]) == gen, bar);
            __builtin_amdgcn_fence(__ATOMIC_ACQUIRE, "agent");
            asm volatile("s_waitcnt vmcnt(0)" ::: "memory");
        }
    }
    __syncthreads();
}

namespace mg {
constexpr int BM = 256, BK = 64, HALF = 128, HTB = HALF * BK * 2, K = 1024, NXCD = 8, WGM = 8;
__host__ __device__ __forceinline__ int lds_byte(int r, int c) { const int st = (r >> 4) * 2 + (c >> 5), rr = r & 15, cc = c & 31, ob = rr * 64 + cc * 2; return st * 1024 + (ob ^ (((ob >> 9) & 1) << 5)); }
__host__ __device__ __forceinline__ void stage_rc(int b, int& R, int& C) { const int st = b / 1024, sb = b % 1024, swz = sb ^ (((sb >> 9) & 1) << 5); R = (st >> 1) * 16 + swz / 64; C = (st & 1) * 32 + (swz % 64) / 2; }
__host__ __device__ __forceinline__ int perm32(int rho) { const int n = rho >> 4, i = rho & 15; return 8 * (i >> 2) + 4 * n + (i & 3); }

struct GUnit { const char* A; const char* B; int slot, pm, pn, aux, lslot; };

struct StaticOrder {
    int nM, nN, nwg, G, c;
    __device__ void init(int M_, int N_, int G_, int c_) { nM = M_ / BM; nN = N_ / BM; nwg = nM * nN; G = G_; c = c_; }
    __device__ bool next(int i, int& pm, int& pn) const {
        const long L = (long)i * G + c; if (L >= nwg) return false;
        int wgid = (int)L; { const int q = nwg / NXCD, r = nwg % NXCD, xcd = wgid % NXCD, off = wgid / NXCD; wgid = (xcd < r ? xcd * (q + 1) : r * (q + 1) + (xcd - r) * q) + off; }
        const int nig = WGM * nN, gid = wgid / nig, fm = gid * WGM, gsz = (nM - fm) < WGM ? (nM - fm) : WGM;
        pm = fm + ((wgid % nig) % gsz); pn = (wgid % nig) / gsz; return true;
    }
};

template <int ROWB, bool GATHER> __device__ __forceinline__ void unit_offs(LAS unsigned char* lds, const GUnit& u, const int (&RA)[2], const int (&CA2)[2], unsigned (&o0)[2], unsigned (&o1)[2]) {
#pragma unroll
    for (int i = 0; i < 2; ++i) {
        int r0 = RA[i], r1 = HALF + RA[i];
        if constexpr (GATHER) { if (u.slot >= 0) { const LAS int* ix = (const LAS int*)(lds + MISC_OFF + MISC_IDX) + u.slot * 256; const int e0 = ix[r0], e1 = ix[r1]; r0 = e0 < 0 ? 0 : (e0 >> 2); r1 = e1 < 0 ? 0 : (e1 >> 2); } else { r0 += u.pm * 256; r1 += u.pm * 256; } }
        o0[i] = (unsigned)r0 * (unsigned)ROWB + (unsigned)CA2[i]; o1[i] = (unsigned)r1 * (unsigned)ROWB + (unsigned)CA2[i];
    }
}

template <class Epi, class Sched>
__device__ __forceinline__ void gemm_phase(LAS unsigned char* lds, const Sched& S, const Epi& E) {
    constexpr int ROWB = Epi::ROWB, NT = ROWB / 128; constexpr bool GATHER = Sched::GATHER;
    const int tid = threadIdx.x, wid = __builtin_amdgcn_readfirstlane(tid >> 6), lane = tid & 63, wr = wid >> 2, wc = wid & 3, fr = lane & 15, fq = lane >> 4;
    int RA[2], CA2[2]; unsigned voffB[2];
#pragma unroll
    for (int i = 0; i < 2; ++i) { int R, C; stage_rc(tid * 16 + i * 8192, R, C); const int Rb = (Epi::PERM64) ? (64 * (R >> 5) + 16 * ((R >> 2) & 3) + 4 * ((R >> 4) & 1) + (R & 3)) : Epi::PERM ? ((R & ~31) + perm32(R & 31)) : R;
        RA[i] = R; CA2[i] = C * 2; voffB[i] = (unsigned)(Rb * ROWB + C * 2); }
    constexpr size_t kstep = (size_t)(BK * 2);
    constexpr size_t hstepB = (size_t)(Epi::PERM64 ? 8 : HALF) * ROWB;
    const unsigned ldsw = (unsigned)wid * 1024u;
    const int aoff = lds_byte(wr * 64 + fr, fq * 8), boff = lds_byte(wc * 32 + fr, fq * 8);
#define MG_SA(b, h) (((b) * 2 + (h)) * HTB)
#define MG_SB(b, h) ((4 + (b) * 2 + (h)) * HTB)
#define MG_STAGE(bufoff, gbase, voff) do { _Pragma("unroll") for (int _i = 0; _i < 2; ++_i) \
        __builtin_amdgcn_global_load_lds((const unsigned*)((const char*)(gbase) + (voff)[_i]), (LAS unsigned*)(lds + (bufoff) + ldsw + _i * 8192), 16, 0, 0); } while (0)
#define MG_LDA(dst, b, h) do { _Pragma("unroll") for (int m = 0; m < 4; ++m) { const i32x4 lo_ = *(const LAS i32x4*)(lds + MG_SA(b, h) + aoff + m * 2048), hi_ = *(const LAS i32x4*)(lds + MG_SA(b, h) + aoff + m * 2048 + 1024); dst[m] = __builtin_shufflevector(lo_, hi_, 0, 1, 2, 3, 4, 5, 6, 7); } } while (0)
#define MG_LDB(dst, b, h) do { _Pragma("unroll") for (int n = 0; n < 2; ++n) { const i32x4 lo_ = *(const LAS i32x4*)(lds + MG_SB(b, h) + boff + n * 2048), hi_ = *(const LAS i32x4*)(lds + MG_SB(b, h) + boff + n * 2048 + 1024); dst[n] = __builtin_shufflevector(lo_, hi_, 0, 1, 2, 3, 4, 5, 6, 7); } } while (0)
#define MG_MMA(ai, bj, At, Bt) do { __builtin_amdgcn_s_setprio(1); _Pragma("unroll") for (int m = 0; m < 4; ++m) _Pragma("unroll") for (int n = 0; n < 2; ++n) { \
        if constexpr (Epi::F8) { acc[ai][bj][m][n] = __builtin_amdgcn_mfma_scale_f32_16x16x128_f8f6f4(Bt[n], At[m], acc[ai][bj][m][n], 0, 0, 0, W8_MFMA_SCALE, 0, 0x7f7f7f7f); } \
        else { acc[ai][bj][m][n] = __builtin_amdgcn_mfma_f32_16x16x32_bf16(__builtin_bit_cast(bf16x8, __builtin_shufflevector(Bt[n], Bt[n], 0, 1, 2, 3)), __builtin_bit_cast(bf16x8, __builtin_shufflevector(At[m], At[m], 0, 1, 2, 3)), acc[ai][bj][m][n], 0, 0, 0); \
               acc[ai][bj][m][n] = __builtin_amdgcn_mfma_f32_16x16x32_bf16(__builtin_bit_cast(bf16x8, __builtin_shufflevector(Bt[n], Bt[n], 4, 5, 6, 7)), __builtin_bit_cast(bf16x8, __builtin_shufflevector(At[m], At[m], 4, 5, 6, 7)), acc[ai][bj][m][n], 0, 0, 0); } } \
        __builtin_amdgcn_s_setprio(0); } while (0)
#define MG_WAIT_V(n) asm volatile("s_waitcnt vmcnt(" #n ")" ::: "memory")
#define MG_WAIT_L(n) asm volatile("s_waitcnt lgkmcnt(" #n ")" ::: "memory")
#define MG_BAR __builtin_amdgcn_s_barrier()
#define MG_SCHED __builtin_amdgcn_sched_barrier(0)
    GUnit cur, nxt; int ui = 0;
    if (!S.next(0, cur)) return;
    f32x4 acc[2][2][4][2];
    E.init(acc, cur, wr, wc, fr, fq);
    i32x8 At[4], B0[2], B1[2];
    unsigned cA0[2], cA1[2];
    unit_offs<ROWB, GATHER>(lds, cur, RA, CA2, cA0, cA1);
    const char* cAp = cur.A; const char* cBp = cur.B;
    MG_STAGE(MG_SB(0, 0), cBp, voffB); MG_STAGE(MG_SB(0, 1), cBp + hstepB, voffB); MG_STAGE(MG_SA(0, 0), cAp, cA0); MG_STAGE(MG_SA(0, 1), cAp, cA1);
    if (wr == 1) MG_BAR;
    MG_WAIT_V(2); MG_BAR;
    MG_STAGE(MG_SB(1, 0), cBp + kstep, voffB); MG_STAGE(MG_SA(1, 0), cAp + kstep, cA0); MG_STAGE(MG_SB(1, 1), cBp + hstepB + kstep, voffB);
    MG_WAIT_V(6); MG_BAR;
    for (;;) {
        const bool has_next = S.next(ui + 1, nxt);
        const char* nAp = has_next ? nxt.A : cAp; const char* nBp = has_next ? nxt.B : cBp;
#pragma unroll 1
        for (int t = 0; t < NT; t += 2) {
            const bool last = (t == NT - 2);
            const char* a1 = cAp + (size_t)(t + 1) * kstep;
            const char* a2 = last ? nAp : cAp + (size_t)(t + 2) * kstep; const char* b2 = last ? nBp : cBp + (size_t)(t + 2) * kstep;
            const char* a3 = a2 + kstep; const char* b3 = b2 + kstep;
            MG_LDB(B0, 0, 0); MG_LDB(B1, 0, 1); MG_LDA(At, 0, 0); MG_STAGE(MG_SA(1, 1), a1, cA1);
            if constexpr (GATHER) { if (last && has_next) unit_offs<ROWB, GATHER>(lds, nxt, RA, CA2, cA0, cA1); }
            MG_WAIT_V(8); MG_WAIT_L(0); MG_BAR; MG_MMA(0, 0, At, B0); MG_MMA(0, 1, At, B1); MG_BAR; MG_SCHED;
            MG_LDA(At, 0, 1); MG_STAGE(MG_SB(0, 0), b2, voffB); MG_STAGE(MG_SB(0, 1), b2 + hstepB, voffB); MG_STAGE(MG_SA(0, 0), a2, cA0);
            MG_WAIT_V(8); MG_WAIT_L(0); MG_BAR; MG_MMA(1, 0, At, B0); MG_MMA(1, 1, At, B1); MG_BAR; MG_SCHED;
            MG_LDB(B0, 1, 0); MG_LDB(B1, 1, 1); MG_LDA(At, 1, 0); MG_STAGE(MG_SA(0, 1), a2, cA1);
            MG_WAIT_V(8); MG_WAIT_L(0); MG_BAR; MG_MMA(0, 0, At, B0); MG_MMA(0, 1, At, B1); MG_BAR; MG_SCHED;
            MG_LDA(At, 1, 1); MG_STAGE(MG_SB(1, 0), b3, voffB); MG_STAGE(MG_SB(1, 1), b3 + hstepB, voffB); MG_STAGE(MG_SA(1, 0), a3, cA0);
            MG_WAIT_V(8); MG_WAIT_L(0); MG_BAR; MG_MMA(1, 0, At, B0); MG_MMA(1, 1, At, B1); MG_BAR; MG_SCHED;
        }
        if (wr == 0) MG_BAR;
        E(acc, cur, nxt, has_next, wr, wc, fr, fq);
        if (!has_next) break;
        cur = nxt; cAp = nAp; cBp = nBp; ++ui;
        if (wr == 1) MG_BAR;
    }
    MG_WAIT_V(0);
    MG_BAR;
#undef MG_SA
#undef MG_SB
#undef MG_STAGE
#undef MG_LDA
#undef MG_LDB
#undef MG_MMA
#undef MG_WAIT_V
#undef MG_WAIT_L
#undef MG_BAR
#undef MG_SCHED
}

template <int ROWB = 2048> struct DenseSched {
    static constexpr bool GATHER = (ROWB == 1024);
    StaticOrder so; const char* A; const char* Bt;
    __device__ __forceinline__ bool next(int i, GUnit& u) const {
        int pm, pn; if (!so.next(i, pm, pn)) return false;
        u.A = GATHER ? A : A + (size_t)pm * (256 * ROWB); u.B = Bt + (size_t)pn * (256 * ROWB); u.slot = GATHER ? -1 : 0; u.lslot = 0; u.pm = pm; u.pn = pn; u.aux = 0; return true;
    }
};
struct MixSched {
    static constexpr bool GATHER = false;
    StaticOrder so; const char* A0; const char* A1; const char* B0; const char* B1;
    __device__ __forceinline__ bool next(int s, GUnit& u) const {
        int pm, pn; if (!so.next(s >> 1, pm, pn)) return false;
        const int part = s & 1;
        u.A = (part ? A1 : A0) + (size_t)pm * (256 * K * 2); u.B = (part ? B1 : B0) + (size_t)pn * (256 * K * 2); u.slot = 0; u.lslot = 0; u.pm = pm; u.pn = pn; u.aux = part; return true;
    }
};
template <int NCOL, bool GATHER_, int ROWB> struct MoeSched {
    static constexpr bool GATHER = true;
    const LAS int* tbl; int j, G; const char* A; const char* Bt; const int* list;
    __device__ __forceinline__ void preload(LAS unsigned char* lds, int tid) const {
        LAS int* ut = (LAS int*)(lds + MISC_OFF + MISC_UTAB);
        if (tid < IDX_SLOTS) {
            const int total = tbl[NE] * NCOL, Lg = tid * G + j; int e = -1, lrt = 0, rt = 0, pn = 0;
            if (Lg < total) { rt = Lg / NCOL; pn = Lg % NCOL; e = 0; for (int q = 1; q < NE; ++q) e += (tbl[q] <= rt) ? 1 : 0; lrt = rt - tbl[e]; }
            ut[tid * 4 + 0] = e; ut[tid * 4 + 1] = lrt; ut[tid * 4 + 2] = rt; ut[tid * 4 + 3] = pn;
        }
        LDS_WAIT(); __syncthreads();
        LAS int* ix = (LAS int*)(lds + MISC_OFF + MISC_IDX);
        if (GATHER_ && tid < 256) { int vals[IDX_SLOTS];
#pragma unroll
            for (int i = 0; i < IDX_SLOTS; ++i) { const int e = ut[i * 4]; vals[i] = (e >= 0) ? list[(size_t)e * LIST_CAP + ut[i * 4 + 1] * 256 + tid] : -1; }
#pragma unroll
            for (int i = 0; i < IDX_SLOTS; ++i) ix[i * 256 + tid] = vals[i]; }
        LDS_WAIT(); __syncthreads();
    }
    __device__ __forceinline__ bool next(int i, GUnit& u) const {
        if (i >= IDX_SLOTS) return false;
        const LAS int* ut = (const LAS int*)(tbl) + (MISC_UTAB - MISC_TBL) / 4 + i * 4;
        const int e = __builtin_amdgcn_readfirstlane(ut[0]); if (e < 0) return false;
        const int rt = __builtin_amdgcn_readfirstlane(ut[2]), pn = __builtin_amdgcn_readfirstlane(ut[3]);
        u.A = A; u.B = Bt + ((size_t)e * NCOL + pn) * (256 * ROWB);
        u.slot = GATHER_ ? i : -1; u.lslot = i; u.pm = rt; u.pn = pn; u.aux = e; return true;
    }
};

#define FOR_AI_M _Pragma("unroll") for (int ai = 0; ai < 2; ++ai) _Pragma("unroll") for (int m = 0; m < 4; ++m)
#define FOR_BJ_N _Pragma("unroll") for (int bj = 0; bj < 2; ++bj) _Pragma("unroll") for (int n = 0; n < 2; ++n)
__device__ __forceinline__ void acc_fill(f32x4 (&acc)[2][2][4][2], const f32x4 (&bv)[2][2]) { FOR_AI_M { FOR_BJ_N acc[ai][bj][m][n] = bv[bj][n]; } }
template <bool ST> struct EpiInT {
    static constexpr bool PERM = true, PERM64 = false, F8 = true; static constexpr int ROWB = 1024, ID = 1;
    const float* bperm; bf16_t *U, *Q, *KV, *RR, *GA; int opq;
    __device__ __forceinline__ void load_bias(f32x4 (&bv)[2][2], int pn, int wc, int fq) const { const int cw = wc * 32 + 8 * fq; FOR_BJ_N bv[bj][n] = *(const f32x4*)(bperm + pn * 256 + bj * 128 + cw + 4 * n); }
    __device__ __forceinline__ void init(f32x4 (&acc)[2][2][4][2], const GUnit& u, int wr, int wc, int fr, int fq) const { f32x4 bv[2][2]; load_bias(bv, u.pn, wc, fq); acc_fill(acc, bv); }
    __device__ __forceinline__ void operator()(f32x4 (&acc)[2][2][4][2], const GUnit& u, const GUnit& nx, bool has_next, int wr, int wc, int fr, int fq) const {
        const int pn = u.pn, row0 = u.pm * 256 + wr * 64 + fr, cw = wc * 32 + 8 * fq;
        f32x4 nb[2][2]; load_bias(nb, has_next ? nx.pn : pn, wc, fq);
        const size_t gbase = ((size_t)(u.pm * 8 + (pn - 13)) * 64 + (size_t)((wr * 4 + wc) * 8)) * 512 + (size_t)(fq * 16 + fr) * 8;
        FOR_AI_M {
            const int row = row0 + ai * 128 + m * 16;
            if (pn < 8) {
                f32x4 r[2];
#pragma unroll
                for (int n = 0; n < 2; ++n) { const f32x4 a = acc[ai][0][m][n], b = acc[ai][1][m][n]; f32x4 e;
#pragma unroll
                    for (int j = 0; j < 4; ++j) e[j] = fast_exp2(-b[j]);
                    e = e + 1.f;
#pragma unroll
                    for (int j = 0; j < 4; ++j) e[j] = fast_rcp(e[j]);
                    r[n] = a * e; }
                { const u32x4 pk = pack8(r[0], r[1]); if constexpr (!ST) asm volatile("" :: "v"(pk)); if (ST || opq) *(u32x4*)(U + (size_t)row * D + pn * 128 + cw) = pk; }
            } else if (pn < 12) {
#pragma unroll
                for (int bj = 0; bj < 2; ++bj) { const u32x4 pk = pack8(acc[ai][bj][m][0], acc[ai][bj][m][1]); if constexpr (!ST) asm volatile("" :: "v"(pk)); if (ST || opq) *(u32x4*)(Q + (size_t)row * D + (pn - 8) * 256 + bj * 128 + cw) = pk; }
            } else if (pn == 12) {
#pragma unroll
                for (int bj = 0; bj < 2; ++bj) { const u32x4 pk = pack8(acc[ai][bj][m][0], acc[ai][bj][m][1]); if constexpr (!ST) asm volatile("" :: "v"(pk)); if (ST || opq) *(u32x4*)(KV + (size_t)row * 256 + bj * 128 + cw) = pk; }
            } else {
                f32x4 rr[2], ga[2];
#pragma unroll
                for (int n = 0; n < 2; ++n) {
                    f32x4 ea, eb;
#pragma unroll
                    for (int j = 0; j < 4; ++j) { ea[j] = fast_exp2(-__builtin_amdgcn_fmed3f(acc[ai][0][m][n][j], -60.f, 60.f)); eb[j] = fast_exp2(-__builtin_amdgcn_fmed3f(acc[ai][1][m][n][j], -60.f, 60.f)); }
                    ea = ea + 1.f; eb = eb + 1.f;
                    f32x4 ia, ib;
#pragma unroll
                    for (int j = 0; j < 4; ++j) { ia[j] = fast_rcp(ea[j]); ib[j] = fast_rcp(eb[j]); }
                    ga[n] = ib; rr[n] = eb * ia;
                }
                const size_t o = gbase + (size_t)((ai * 4 + m) * 512);
                { const u32x4 p0 = pack8(rr[0], rr[1]), p1 = pack8(ga[0], ga[1]); if constexpr (!ST) asm volatile("" :: "v"(p0), "v"(p1)); if (ST || opq) { __builtin_nontemporal_store(p0, (u32x4*)(RR + o)); __builtin_nontemporal_store(p1, (u32x4*)(GA + o)); } }
            }
            FOR_BJ_N acc[ai][bj][m][n] = nb[bj][n];
        }
    }
};
using EpiIn = EpiInT<true>;
struct EpiMix {
    static constexpr bool PERM = true, PERM64 = false, F8 = false; static constexpr int ROWB = 2048, ID = 3;
    const bf16_t *RR, *GA; const float *bco, *bao; bf16_t* MIX;
    __device__ __forceinline__ void load_bias(f32x4 (&bv)[2][2], const float* bias, int pn, int wc, int fq) const { const int c0 = pn * 256 + wc * 32 + 8 * fq; FOR_BJ_N bv[bj][n] = *(const f32x4*)(bias + c0 + bj * 128 + 4 * n); }
    __device__ __forceinline__ void init(f32x4 (&acc)[2][2][4][2], const GUnit& u, int wr, int wc, int fr, int fq) const { f32x4 bv[2][2]; load_bias(bv, bco, u.pn, wc, fq); acc_fill(acc, bv); }
    __device__ __forceinline__ void operator()(f32x4 (&acc)[2][2][4][2], const GUnit& u, const GUnit& nx, bool has_next, int wr, int wc, int fr, int fq) const {
        const int row0 = u.pm * 256 + wr * 64 + fr, col0 = u.pn * 256 + wc * 32 + 8 * fq;
        const bool part1 = (u.aux != 0);
        f32x4 nb[2][2]; load_bias(nb, part1 ? bco : bao, part1 ? (has_next ? nx.pn : u.pn) : u.pn, wc, fq);
        const bf16_t* Gb = (part1 ? GA : RR) + ((size_t)(u.pm * 8 + 2 * u.pn) * 64 + (size_t)((wr * 4 + wc) * 8)) * 512 + (size_t)(fq * 16 + fr) * 8;
        u32x4 gt[2][4][2];
        FOR_AI_M {
#pragma unroll
            for (int bj = 0; bj < 2; ++bj) gt[ai][m][bj] = __builtin_nontemporal_load((const u32x4*)(Gb + (size_t)(bj * 32768 + (ai * 4 + m) * 512))); }
        FOR_AI_M {
            const size_t ro = (size_t)(row0 + ai * 128 + m * 16) * D + col0;
#pragma unroll
            for (int bj = 0; bj < 2; ++bj) {
                const u32x4 g = gt[ai][m][bj];
                const f32x4 g0 = (f32x4){bf_lo(g.x), bf_hi(g.x), bf_lo(g.y), bf_hi(g.y)}, g1 = (f32x4){bf_lo(g.z), bf_hi(g.z), bf_lo(g.w), bf_hi(g.w)};
                if (part1) { *(u32x4*)(MIX + ro + bj * 128) = pack8(acc[ai][bj][m][0] * g0, acc[ai][bj][m][1] * g1); acc[ai][bj][m][0] = nb[bj][0]; acc[ai][bj][m][1] = nb[bj][1]; }
                else { acc[ai][bj][m][0] = acc[ai][bj][m][0] * g0 + nb[bj][0]; acc[ai][bj][m][1] = acc[ai][bj][m][1] * g1 + nb[bj][1]; }
            }
        }
    }
};
struct EpiRes {
    static constexpr bool PERM = true, PERM64 = false, F8 = false; static constexpr int ROWB = 2048, ID = 4;
    const float* x; bf16_t* X1B;
    __device__ __forceinline__ void init(f32x4 (&acc)[2][2][4][2], const GUnit& u, int wr, int wc, int fr, int fq) const { FOR_AI_M { FOR_BJ_N acc[ai][bj][m][n] = (f32x4){0.f, 0.f, 0.f, 0.f}; } }
    __device__ __forceinline__ void operator()(f32x4 (&acc)[2][2][4][2], const GUnit& u, const GUnit& nx, bool has_next, int wr, int wc, int fr, int fq) const {
        const int row0 = u.pm * 256 + wr * 64 + fr, col0 = u.pn * 256 + wc * 32 + 8 * fq;
#pragma unroll
        for (int ai = 0; ai < 2; ++ai) {
            f32x4 xt[4][2][2];
#pragma unroll
            for (int m = 0; m < 4; ++m) { const size_t ro = (size_t)(row0 + ai * 128 + m * 16) * D + col0;
#pragma unroll
                for (int bj = 0; bj < 2; ++bj) { xt[m][bj][0] = __builtin_nontemporal_load((const f32x4*)(x + ro + bj * 128)); xt[m][bj][1] = __builtin_nontemporal_load((const f32x4*)(x + ro + bj * 128 + 4)); } }
#pragma unroll
            for (int m = 0; m < 4; ++m) { const size_t ro = (size_t)(row0 + ai * 128 + m * 16) * D + col0;
#pragma unroll
                for (int bj = 0; bj < 2; ++bj) {
                    *(u32x4*)(X1B + ro + bj * 128) = pack8(xt[m][bj][0] + acc[ai][bj][m][0], xt[m][bj][1] + acc[ai][bj][m][1]);
                    acc[ai][bj][m][0] = (f32x4){0.f, 0.f, 0.f, 0.f}; acc[ai][bj][m][1] = (f32x4){0.f, 0.f, 0.f, 0.f};
                } }
        }
    }
};
struct EpiSwiglu {
    static constexpr bool PERM = true, PERM64 = false, F8 = true; static constexpr int ROWB = 1024, ID = 6;
    const float *bg, *bu; unsigned char* ACT;
    __device__ __forceinline__ void load_bias(f32x4 (&bv)[2][2], int e, int pn, int wc, int fq) const { const int ch0 = pn * 128 + wc * 32 + 8 * fq;
#pragma unroll
        for (int n = 0; n < 2; ++n) { bv[0][n] = *(const f32x4*)(bg + e * D + ch0 + 4 * n) * CGATE; bv[1][n] = *(const f32x4*)(bu + e * D + ch0 + 4 * n) + 1.f; } }
    __device__ __forceinline__ void init(f32x4 (&acc)[2][2][4][2], const GUnit& u, int wr, int wc, int fr, int fq) const { f32x4 bv[2][2]; load_bias(bv, u.aux, u.pn, wc, fq); acc_fill(acc, bv); }
    __device__ __forceinline__ void operator()(f32x4 (&acc)[2][2][4][2], const GUnit& u, const GUnit& nx, bool has_next, int wr, int wc, int fr, int fq) const {
        const int ch0 = u.pn * 128 + wc * 32 + 8 * fq;
        f32x4 nb[2][2]; load_bias(nb, has_next ? nx.aux : u.aux, has_next ? nx.pn : u.pn, wc, fq);
        constexpr float GLIM = 7.f * CGATE;
        FOR_AI_M {
            const int r = ai * 128 + wr * 64 + m * 16 + fr;
            f32x4 a[2];
#pragma unroll
            for (int n = 0; n < 2; ++n) {
                f32x4 gc, uc, e, d;
#pragma unroll
                for (int j = 0; j < 4; ++j) { gc[j] = __builtin_amdgcn_fmed3f(acc[ai][0][m][n][j], -3.0e38f, GLIM); uc[j] = __builtin_amdgcn_fmed3f(acc[ai][1][m][n][j], -6.f, 8.f); }
#pragma unroll
                for (int j = 0; j < 4; ++j) e[j] = fast_exp2(-gc[j]);
                d = e * CGATE + CGATE;
#pragma unroll
                for (int j = 0; j < 4; ++j) d[j] = fast_rcp(d[j]);
                a[n] = (uc * gc) * d;
            }
            u32x2 pk; pk.x = pack4_fp8(a[0][0], a[0][1], a[0][2], a[0][3]); pk.y = pack4_fp8(a[1][0], a[1][1], a[1][2], a[1][3]);
            *(u32x2*)(ACT + (size_t)(u.pm * 256 + r) * D + ch0) = pk;
            FOR_BJ_N acc[ai][bj][m][n] = nb[bj][n];
        }
    }
};
struct EpiDown {
    static constexpr bool PERM = true, PERM64 = true, F8 = true; static constexpr int ROWB = 1024, ID = 7, NST = 0;
    const LAS int* misc; const float* bd; unsigned char* Y;
    __device__ __forceinline__ void load_bias(f32x4 (&bv)[2][2], int e, int pn, int wc, int fq) const { const int c0 = pn * 256 + wc * 64 + 16 * fq; FOR_BJ_N bv[bj][n] = *(const f32x4*)(bd + e * D + c0 + 8 * bj + 4 * n); }
    __device__ __forceinline__ void init(f32x4 (&acc)[2][2][4][2], const GUnit& u, int wr, int wc, int fr, int fq) const { f32x4 bv[2][2]; load_bias(bv, u.aux, u.pn, wc, fq); acc_fill(acc, bv); }
    __device__ __forceinline__ void operator()(f32x4 (&acc)[2][2][4][2], const GUnit& u, const GUnit& nx, bool has_next, int wr, int wc, int fr, int fq) const {
        const int col0 = u.pn * 256 + wc * 64 + 16 * fq;
        const int c0 = __builtin_amdgcn_readfirstlane(misc[MISC_CPRE / 4 + u.aux]), c1 = __builtin_amdgcn_readfirstlane(misc[MISC_CPRE / 4 + u.aux + 1]);
        const int lr0 = 256 * __builtin_amdgcn_readfirstlane(misc[MISC_UTAB / 4 + u.lslot * 4 + 1]);
        const int drow0 = c0 + lr0, nvalid = c1 - c0 - lr0;
        f32x4 nb[2][2]; load_bias(nb, has_next ? nx.aux : u.aux, has_next ? nx.pn : u.pn, wc, fq);
        FOR_AI_M {
            const int r = ai * 128 + wr * 64 + m * 16 + fr;
            const int drow = (r < nvalid) ? drow0 + r : 4 * M;
            u32x4 pk;
#pragma unroll
            for (int bj = 0; bj < 2; ++bj) { const f32x4 v0 = acc[ai][bj][m][0], v1 = acc[ai][bj][m][1];
                pk[2 * bj] = pack4_fp8(v0[0], v0[1], v0[2], v0[3]); pk[2 * bj + 1] = pack4_fp8(v1[0], v1[1], v1[2], v1[3]); }
            *(u32x4*)(Y + (size_t)drow * 1024 + col0) = pk;
            FOR_BJ_N acc[ai][bj][m][n] = nb[bj][n];
        }
    }
};
template <class B> struct EpiNull {
    static constexpr bool PERM = B::PERM, PERM64 = B::PERM64, F8 = B::F8; static constexpr int ROWB = B::ROWB, ID = B::ID;
    B b;
    __device__ __forceinline__ void init(f32x4 (&acc)[2][2][4][2], const GUnit& u, int wr, int wc, int fr, int fq) const { b.init(acc, u, wr, wc, fr, fq); }
    __device__ __forceinline__ void operator()(f32x4 (&acc)[2][2][4][2], const GUnit& u, const GUnit& nx, bool has_next, int wr, int wc, int fr, int fq) const {
        FOR_AI_M { FOR_BJ_N asm volatile("" :: "v"(acc[ai][bj][m][n])); }
        b.init(acc, has_next ? nx : u, wr, wc, fr, fq);
    }
};
#undef FOR_AI_M
#undef FOR_BJ_N
}

struct Args { const float* in[24]; float* out; unsigned char* ws; int ph_lo, ph_hi, li, pad; };
enum { I_X = 0, I_GMIX, I_WIN, I_BIN, I_CONVW, I_CONVB, I_LNG, I_LNB, I_WCO, I_BCO, I_SINKS, I_WAO, I_BAO, I_WOUT, I_GFFN, I_WR, I_BR, I_WG, I_BG, I_WU, I_BU, I_WD, I_BD, I_GFIN };

__device__ __forceinline__ void tr_item(const float* W, int ldw, int k0, int scol0, const float* gscale, bf16_t* WT, int drow0, LAS float* scr, int lane) {
    const int kr = lane >> 3, nc = lane & 7;
#pragma unroll
    for (int it = 0; it < 8; ++it) {
        const int kk = 8 * it + kr; const f32x4 v = __builtin_nontemporal_load((const f32x4*)(W + (size_t)(k0 + kk) * ldw + scol0 + 4 * nc));
        const float g = gscale ? gscale[k0 + kk] : 1.f;
        LAS float* s = scr + kk * 33 + 4 * nc; s[0] = v[0] * g; s[1] = v[1] * g; s[2] = v[2] * g; s[3] = v[3] * g;
    }
    LDS_WAIT(); asm volatile("" ::: "memory");
    const int c = lane & 7;
#pragma unroll
    for (int j = 0; j < 4; ++j) { const int n = (lane >> 3) + 8 * j; const LAS float* s = scr + (8 * c) * 33 + n;
        u32x4 o; o.x = cvt_pk_bf16(s[0 * 33], s[1 * 33]); o.y = cvt_pk_bf16(s[2 * 33], s[3 * 33]); o.z = cvt_pk_bf16(s[4 * 33], s[5 * 33]); o.w = cvt_pk_bf16(s[6 * 33], s[7 * 33]);
        *(u32x4*)(WT + (size_t)(drow0 + n) * D + k0 + 8 * c) = o; }
    LDS_WAIT(); asm volatile("" ::: "memory");
}
struct TrSrc { const float* W; unsigned char* WT; int ldw, k0, scol0, drow0; float cs; };
__device__ __forceinline__ void tr_load(const TrSrc& t, f32x4 (&v)[8], int lane) {
    const int kr = lane >> 3, nc = lane & 7;
#pragma unroll
    for (int it = 0; it < 8; ++it) v[it] = __builtin_nontemporal_load((const f32x4*)(t.W + (size_t)(t.k0 + 8 * it + kr) * t.ldw + t.scol0 + 4 * nc));
}
__device__ __forceinline__ void tr_store_f8(const TrSrc& t, const f32x4 (&v)[8], LAS float* scr, int lane) {
    const int kr = lane >> 3, nc = lane & 7;
#pragma unroll
    for (int it = 0; it < 8; ++it) { const int kk = 8 * it + kr; LAS float* sp = scr + kk * 33 + 4 * nc; sp[0] = v[it][0]; sp[1] = v[it][1]; sp[2] = v[it][2]; sp[3] = v[it][3]; }
    LDS_WAIT(); asm volatile("" ::: "memory");
    const int c = lane & 7; const float cs = t.cs;
#pragma unroll
    for (int j = 0; j < 4; ++j) { const int n = (lane >> 3) + 8 * j; const LAS float* sp = scr + (8 * c) * 33 + n;
        const f32x4 a = (f32x4){sp[0 * 33], sp[1 * 33], sp[2 * 33], sp[3 * 33]} * cs, b = (f32x4){sp[4 * 33], sp[5 * 33], sp[6 * 33], sp[7 * 33]} * cs;
        u32x2 o; o.x = pack4_fp8(a[0], a[1], a[2], a[3]); o.y = pack4_fp8(b[0], b[1], b[2], b[3]);
        *(u32x2*)(t.WT + (size_t)(t.drow0 + n) * D + t.k0 + 8 * c) = o; }
    LDS_WAIT(); asm volatile("" ::: "memory");
}
__device__ __forceinline__ void tr_item_f8(const float* W, int ldw, int k0, int scol0, unsigned char* WT, int drow0, float cs, LAS float* scr, int lane) {
    TrSrc t{W, WT, ldw, k0, scol0, drow0, cs}; f32x4 v[8]; tr_load(t, v, lane); tr_store_f8(t, v, scr, lane);
}
__device__ __forceinline__ int win_src_col(int np) {
    const int pn = np >> 8, j = np & 255;
    if (pn < 8) { const int ch = 128 * pn + (j & 127); return (j < 128) ? ch : 1024 + ch; }
    if (pn < 13) return np;
    const int ch = 128 * (pn - 13) + (j & 127); return (j < 128) ? 3328 + ch : 4352 + ch;
}

__device__ __forceinline__ float win_col_scale(int np) {
    const int pn = np >> 8, j = np & 255;
    if (pn < 8) return (j < 128) ? 1.f : LOG2E;
    if (pn < 12) return QSCALE;
    if (pn == 12) return 1.f;
    return LOG2E;
}

__device__ __forceinline__ void p0_prologue(const Args& args, LAS unsigned char* lds, int vcu, int G, int wave, int lane) {
    unsigned char* ws = args.ws;
    LAS float* scr = (LAS float*)(lds + wave * 16384);
    const int gw = vcu * 8 + wave, NGW = G * 8;
    {
        const float* x = args.in[I_X]; unsigned char* XF8 = ws + WS_R2;
        f32x4 gm[4];
#pragma unroll
        for (int j = 0; j < 4; ++j) gm[j] = *((const f32x4*)args.in[I_GMIX] + lane + 64 * j);
        for (int m0 = gw; m0 < M; m0 += 4 * NGW) {
            f32x4 v[4][4];
#pragma unroll
            for (int q = 0; q < 4; ++q) { const int m = m0 + q * NGW; if (m < M) { const f32x4* xr = (const f32x4*)(x + (size_t)m * D) + lane;
#pragma unroll
                for (int j = 0; j < 4; ++j) v[q][j] = __builtin_nontemporal_load(xr + 64 * j); } }
#pragma unroll
            for (int q = 0; q < 4; ++q) { const int m = m0 + q * NGW; if (m < M) {
                float s = 0.f;
#pragma unroll
                for (int j = 0; j < 4; ++j) s += (v[q][j][0] * v[q][j][0] + v[q][j][1] * v[q][j][1]) + (v[q][j][2] * v[q][j][2] + v[q][j][3] * v[q][j][3]);
                s = wave_sum(s);
                unsigned* o = (unsigned*)(XF8 + (size_t)m * D) + lane;
                const float rs = 1.0f / sqrtf(s * (1.f / D) + EPS);
#pragma unroll
                for (int j = 0; j < 4; ++j) { const f32x4 t = v[q][j] * rs * gm[j]; o[64 * j] = pack4_fp8(t[0], t[1], t[2], t[3]); } } }
        }
    }
    {
        constexpr int I_IN = 16 * (NIN / 32), I_SQ = 16 * 32, NITEMS = I_IN + 3 * I_SQ;
        for (int it = gw; it < NITEMS; it += NGW) {
            int r = it;
            if (r < I_IN) { const int kb = r / (NIN / 32), db = r % (NIN / 32); tr_item_f8(args.in[I_WIN], NIN, 64 * kb, win_src_col(32 * db), ws + WS_WIN, 32 * db, W8SCALE * win_col_scale(32 * db), scr, lane); continue; }
            r -= I_IN;
            const int which = r / I_SQ; r -= which * I_SQ; const int kb = r / 32, db = r % 32;
            const float* W = which == 0 ? args.in[I_WCO] : which == 1 ? args.in[I_WAO] : args.in[I_WOUT];
            bf16_t* WT = (bf16_t*)(ws + (which == 0 ? WS_WCO : which == 1 ? WS_WAO : WS_WO));
            tr_item(W, D, 64 * kb, 32 * db, nullptr, WT, 32 * db, scr, lane);
        }
    }
    {
        const int gt = (vcu * 8 + wave) * 64 + lane, NT_ = G * 512;
        float* bperm = (float*)(ws + WS_BPERM); const float* b_in = args.in[I_BIN];
        for (int i = gt; i < NIN; i += NT_) bperm[i] = b_in[win_src_col(i)] * win_col_scale(i);
        { bf16_t* wrt = (bf16_t*)(ws + WS_WRT); const float* wr = args.in[I_WR]; const float* gf = args.in[I_GFFN];
          for (int i = gt; i < D * NE; i += NT_) { const int k = i >> 5, e = i & 31; wrt[e * D + k] = (bf16_t)(cvt_pk_bf16(wr[i] * gf[k], 0.f) & 0xffffu); } }
        int* list = (int*)(ws + WS_LIST);
        for (int i = gt; i < NE * LIST_CAP / 4; i += NT_) ((int4*)list)[i] = make_int4(-1, -1, -1, -1);
    }
}
__device__ __forceinline__ TrSrc expert_half(const Args& args, int q, int h) {
    constexpr int P_GU = 8 * 64, PER_E = P_GU + 8 * 32;
    unsigned char* ws = args.ws;
    const int e = q / PER_E; int r = q % PER_E; TrSrc t;
    if (r < P_GU) { const int kp = r / 64, db = r % 64, np = 32 * db, pn = np >> 8, j = np & 255, ch = 128 * pn + (j & 127);
        t.W = ((j < 128) ? args.in[I_WG] : args.in[I_WU]) + (size_t)e * D * D; t.cs = (j < 128) ? W8SCALE * CGATE : W8SCALE; t.WT = ws + WS_WGU + (size_t)e * 2048 * D; t.ldw = D; t.k0 = 128 * kp + 64 * h; t.scol0 = ch; t.drow0 = np; }
    else { r -= P_GU; const int kp = r / 32, db = r % 32;
        t.W = args.in[I_WD] + (size_t)e * D * D; t.cs = W8SCALE; t.WT = ws + WS_WD + (size_t)e * D * D; t.ldw = D; t.k0 = 128 * kp + 64 * h; t.scol0 = 32 * db; t.drow0 = 32 * db; }
    return t;
}
__device__ __forceinline__ void tr_stage_f8(const TrSrc& t, const f32x4 (&v)[8], LAS float* scr, LAS unsigned char* img, int h, int lane) {
    const int kr = lane >> 3, nc = lane & 7;
#pragma unroll
    for (int it = 0; it < 8; ++it) { const int kk = 8 * it + kr; LAS float* sp = scr + kk * 33 + 4 * nc; sp[0] = v[it][0]; sp[1] = v[it][1]; sp[2] = v[it][2]; sp[3] = v[it][3]; }
    LDS_WAIT(); asm volatile("" ::: "memory");
    const int c = lane & 7; const float cs = t.cs;
#pragma unroll
    for (int j = 0; j < 4; ++j) { const int n = (lane >> 3) + 8 * j; const LAS float* sp = scr + (8 * c) * 33 + n;
        const f32x4 a = (f32x4){sp[0 * 33], sp[1 * 33], sp[2 * 33], sp[3 * 33]} * cs, b = (f32x4){sp[4 * 33], sp[5 * 33], sp[6 * 33], sp[7 * 33]} * cs;
        u32x2 o; o.x = pack4_fp8(a[0], a[1], a[2], a[3]); o.y = pack4_fp8(b[0], b[1], b[2], b[3]);
        *(LAS u32x2*)(img + n * 128 + h * 64 + 8 * c) = o; }
    LDS_WAIT(); asm volatile("" ::: "memory");
}
__device__ __forceinline__ void pair_flush(const TrSrc& t, const LAS unsigned char* img, int lane) {
#pragma unroll
    for (int j = 0; j < 4; ++j) { const int n = (lane >> 3) + 8 * j, pc = lane & 7;
        const u32x4 v = *(const LAS u32x4*)(img + n * 128 + 16 * pc);
        __builtin_nontemporal_store(v, (u32x4*)(t.WT + (size_t)(t.drow0 + n) * D + t.k0 + 16 * pc)); }
    LDS_WAIT(); asm volatile("" ::: "memory");
}
constexpr int CV_E0 = 4, CV_E1 = 8;
constexpr int CV_FILL = CVF_PAIRS * 2048;
constexpr int CV_POOL0 = CV_E0 * 512, CV_POOL1 = CV_E1 * 256, CV_POOL2 = NE * 768 - CV_POOL0 - CV_POOL1 - 2 * CV_FILL;
__device__ __forceinline__ int pool_pair(int pool, int i) {
    constexpr int NGU = NE * 512, GU_REST = NGU - CV_POOL0 - 2 * CV_FILL;
    int gi;
    if (pool == 0) gi = i;
    else if (pool == 3) gi = CV_POOL0 + i;
    else if (pool == 4) gi = CV_POOL0 + CV_FILL + i;
    else if (pool == 1) gi = NGU + i;
    else gi = (i < GU_REST) ? CV_POOL0 + 2 * CV_FILL + i : NGU + CV_POOL1 + (i - GU_REST);
    if (gi < NGU) return (gi >> 9) * 768 + (gi & 511);
    gi -= NGU; return (gi >> 8) * 768 + 512 + (gi & 255);
}
struct NoPre { __device__ __forceinline__ void operator()() const {} };
template <class Pre = NoPre> __device__ __forceinline__ void p5_expert_weights(const Args& args, LAS unsigned char* lds, int pool, int gw, int NGW, int NPAIRS, int wave, int lane, Pre pre = Pre()) {
    LAS float* scr = (LAS float*)(lds + wave * 16384); LAS unsigned char* img = lds + wave * 16384 + 8448;
    const int mine = (gw < NPAIRS) ? (NPAIRS - gw + NGW - 1) / NGW : 0;
    const int ncpl = mine / 2;
    f32x4 va[8], vb[8], vc[8], vd[8];
    TrSrc ta, tb, tc, td;
    int it = gw;
    if (ncpl > 0) {
        ta = expert_half(args, pool_pair(pool, it), 0); tr_load(ta, va, lane); tb = expert_half(args, pool_pair(pool, it), 1); tr_load(tb, vb, lane);
        tc = expert_half(args, pool_pair(pool, it + NGW), 0); tr_load(tc, vc, lane); td = expert_half(args, pool_pair(pool, it + NGW), 1); tr_load(td, vd, lane);
    }
    pre();
    if (ncpl > 0) {
#pragma unroll 1
        for (int q = 0; q + 1 < ncpl; ++q) {
            it += 2 * NGW;
            { const TrSrc f = ta; tr_stage_f8(ta, va, scr, img, 0, lane); ta = expert_half(args, pool_pair(pool, it), 0); tr_load(ta, va, lane);
              tr_stage_f8(tb, vb, scr, img, 1, lane); tb = expert_half(args, pool_pair(pool, it), 1); tr_load(tb, vb, lane); pair_flush(f, img, lane); }
            { const TrSrc f = tc; tr_stage_f8(tc, vc, scr, img, 0, lane); tc = expert_half(args, pool_pair(pool, it + NGW), 0); tr_load(tc, vc, lane);
              tr_stage_f8(td, vd, scr, img, 1, lane); td = expert_half(args, pool_pair(pool, it + NGW), 1); tr_load(td, vd, lane); pair_flush(f, img, lane); }
        }
        tr_stage_f8(ta, va, scr, img, 0, lane); tr_stage_f8(tb, vb, scr, img, 1, lane); pair_flush(ta, img, lane);
        tr_stage_f8(tc, vc, scr, img, 0, lane); tr_stage_f8(td, vd, scr, img, 1, lane); pair_flush(tc, img, lane);
        it += 2 * NGW;
    }
    if (mine & 1) {
        ta = expert_half(args, pool_pair(pool, it), 0); tr_load(ta, va, lane); tb = expert_half(args, pool_pair(pool, it), 1); tr_load(tb, vb, lane);
        tr_stage_f8(ta, va, scr, img, 0, lane); tr_stage_f8(tb, vb, scr, img, 1, lane); pair_flush(ta, img, lane);
    }
}

template <class Pre = NoPre> __device__ __forceinline__ void conv_phase(const Args& args, LAS unsigned char* lds, int vcu, int G, int tid, int wave, int lane, Pre pre = Pre()) {
    unsigned char* ws = args.ws;
    const unsigned* U32 = (const unsigned*)(ws + WS_U); bf16_t* C = (bf16_t*)(ws + WS_R2);
    const float* cw = args.in[I_CONVW]; const float* cb = args.in[I_CONVB]; const float* lng = args.in[I_LNG]; const float* lnb = args.in[I_LNB];
    LAS float* T = (LAS float*)lds;
    f32x2 w[KCONV];
#pragma unroll
    for (int j = 0; j < KCONV; ++j) w[j] = *(const f32x2*)(cw + j * D + 2 * tid);
    const f32x2 cbv = *(const f32x2*)(cb + 2 * tid);
    LAS f32x4* lgb = (LAS f32x4*)(lds + MISC_OFF + MISC_IDX);
    if (tid < 256) { lgb[tid] = ((const f32x4*)lng)[tid]; lgb[256 + tid] = ((const f32x4*)lnb)[tid]; }
    pre();
    unsigned raw[62];
#define CONV_LOAD(unx) do { const int b_ = (unx) / (SEQ / 32), t0_ = ((unx) % (SEQ / 32)) * 32; const size_t rb_ = (size_t)b_ * SEQ; \
        _Pragma("unroll") for (int s = 0; s < 62; ++s) { const int ts = t0_ - 30 + s; const unsigned v_ = U32[(rb_ + (size_t)(ts < 0 ? 0 : ts)) * (D / 2) + tid]; raw[s] = (ts >= 0) ? v_ : 0u; } } while (0)
    if (vcu < BATCH * (SEQ / 32)) CONV_LOAD(vcu);
    for (int un = vcu; un < BATCH * (SEQ / 32); un += G) {
        const int b = un / (SEQ / 32), t0 = (un % (SEQ / 32)) * 32;
        const size_t rowbase = (size_t)b * SEQ;
        f32x2 in[62];
#pragma unroll
        for (int s = 0; s < 62; ++s) in[s] = (f32x2){bf_lo(raw[s]), bf_hi(raw[s])};
#define CONV_O(o) { f32x2 a_ = cbv; _Pragma("unroll") for (int j = 0; j < KCONV; ++j) a_ = w[j] * in[(o) + j] + a_; *(LAS f32x2*)(T + (o) * D + 2 * tid) = a_; }
        CONV_O(0) CONV_O(1) CONV_O(2) CONV_O(3) CONV_O(4) CONV_O(5) CONV_O(6) CONV_O(7) CONV_O(8) CONV_O(9) CONV_O(10) CONV_O(11) CONV_O(12) CONV_O(13) CONV_O(14) CONV_O(15)
        CONV_O(16) CONV_O(17) CONV_O(18) CONV_O(19) CONV_O(20) CONV_O(21) CONV_O(22) CONV_O(23) CONV_O(24) CONV_O(25) CONV_O(26) CONV_O(27) CONV_O(28) CONV_O(29) CONV_O(30) CONV_O(31)
#undef CONV_O
        if (un + G < BATCH * (SEQ / 32)) CONV_LOAD(un + G);
        LDS_WAIT(); __builtin_amdgcn_s_barrier(); asm volatile("" ::: "memory");
#pragma unroll 2
        for (int i = 0; i < 4; ++i) {
            const int o = 4 * wave + i;
            f32x4 v[4]; float s = 0.f;
#pragma unroll
            for (int c = 0; c < 4; ++c) { v[c] = *(const LAS f32x4*)(T + o * D + 256 * c + 4 * lane); s += (v[c][0] + v[c][1]) + (v[c][2] + v[c][3]); }
            const float mean = wave_sum(s) * (1.f / D); float q = 0.f;
#pragma unroll
            for (int c = 0; c < 4; ++c) { v[c] = v[c] - mean; q += (v[c][0] * v[c][0] + v[c][1] * v[c][1]) + (v[c][2] * v[c][2] + v[c][3] * v[c][3]); }
            const float rstd = 1.0f / sqrtf(wave_sum(q) * (1.f / D) + EPS);
            u32x2* op = (u32x2*)(C + (rowbase + t0 + o) * D) + lane;
#pragma unroll
            for (int c = 0; c < 4; ++c) {
                f32x4 y = v[c] * rstd * lgb[64 * c + lane] + lgb[256 + 64 * c + lane];
#pragma unroll
                for (int j = 0; j < 4; ++j) y[j] = y[j] * sigmoid_f(y[j]);
                u32x2 pk; pk.x = cvt_pk_bf16(y[0], y[1]); pk.y = cvt_pk_bf16(y[2], y[3]); op[64 * c] = pk;
            }
        }
        LDS_WAIT(); __builtin_amdgcn_s_barrier(); asm volatile("" ::: "memory");
    }
}

#undef CONV_LOAD
constexpr int AT_K = 0, AT_V = 32768, AT_OST = 65536;
__device__ __forceinline__ int crow(int r, int hi) { return (r & 3) + 8 * (r >> 2) + 4 * hi; }
__device__ __forceinline__ s16x4 vtr(const LAS unsigned char* p) { typedef short v4i16_t __attribute__((ext_vector_type(4))); return __builtin_bit_cast(s16x4, __builtin_amdgcn_ds_read_tr16_b64_v4i16((LAS v4i16_t*)p)); }
__device__ __forceinline__ void attn_phase(const Args& args, LAS unsigned char* lds, int vcu, int G, int wave, int lane) {
    unsigned char* ws = args.ws;
    const bf16_t* KV = (const bf16_t*)(ws + WS_KV); bf16_t* QO = (bf16_t*)(ws + WS_QO);
    const int r32 = lane & 31, hi = lane >> 5;
    const LAS unsigned char* kbase = lds + AT_K + hi * 1024 + r32 * 16;
    const LAS unsigned char* vbase = lds + AT_V + ((lane >> 4) & 1) * 32 + (lane & 3) * 8 + (4 * hi + ((lane & 15) >> 2)) * 64;
    LAS bf16_t* stg = (LAS bf16_t*)(lds + AT_OST + wave * 4096);
    const int dq = r32 - 4 * hi;
    for (int un = vcu; un < BATCH * 2 * (SEQ / 128); un += G) {
        const int qb = un % (SEQ / 128), kvh = (un / (SEQ / 128)) & 1, b = un / (2 * (SEQ / 128));
        const int h = kvh * 8 + wave;
        const long T0 = (long)b * SEQ + 128 * qb;
#pragma unroll
        for (int t = 0; t < 4; ++t) {
            if (qb > 0 || t >= 2) {
                const long tok0 = T0 - 128 + 64 * t;
                const bf16_t* ks = KV + (size_t)(tok0 + lane) * 256 + kvh * 64 + wave * 8;
                const bf16_t* vs = KV + (size_t)(tok0 + 16 * (wave & 3) + (lane >> 2)) * 256 + 128 + kvh * 64 + (wave >> 2) * 32 + (lane & 3) * 8;
                __builtin_amdgcn_global_load_lds((const unsigned*)ks, (LAS unsigned*)(lds + AT_K + t * 8192 + wave * 1024), 16, 0, 0);
                __builtin_amdgcn_global_load_lds((const unsigned*)vs, (LAS unsigned*)(lds + AT_V + t * 8192 + wave * 1024), 16, 0, 0);
            }
        }
        const float slope2 = fast_exp2(-0.5f * (float)(h + 1)) * LOG2E;
        const float sink2 = args.in[I_SINKS][h] * LOG2E;
        f32x16 bias0;
#pragma unroll
        for (int r = 0; r < 16; ++r) bias0[r] = -slope2 * (float)(r32 - crow(r, hi));
        float drel[5];
#pragma unroll
        for (int rel = 0; rel < 5; ++rel) drel[rel] = fast_exp2(-32.f * (float)(4 - rel) * slope2);
        asm volatile("s_waitcnt vmcnt(0)" ::: "memory"); __builtin_amdgcn_s_barrier(); asm volatile("" ::: "memory");
#pragma unroll 1
        for (int qs = 0; qs < 4; ++qs) {
            const bf16_t* Qw = QO + (size_t)(T0 + 32 * qs + r32) * D + h * 64 + hi * 8;
            bf16x8 qr[4];
#pragma unroll
            for (int d0 = 0; d0 < 4; ++d0) qr[d0] = __builtin_nontemporal_load((const bf16x8*)(Qw + d0 * 16));
            f32x16 S[5];
#pragma unroll
            for (int rel = 0; rel < 5; ++rel) {
                const int blk = qs + rel;
                const bool valid = (qb > 0) || (blk >= 4);
                if (valid) {
                    S[rel] = bias0;
                    const LAS unsigned char* kp = kbase + (blk >> 1) * 8192 + (blk & 1) * 512;
#pragma unroll
                    for (int d0 = 0; d0 < 4; ++d0) { const bf16x8 kf = *(const LAS bf16x8*)(kp + d0 * 2048); S[rel] = __builtin_amdgcn_mfma_f32_32x32x16_bf16(kf, qr[d0], S[rel], 0, 0, 0); }
                } else {
#pragma unroll
                    for (int r = 0; r < 16; ++r) S[rel][r] = -INFINITY;
                }
            }
#pragma unroll
            for (int r = 0; r < 16; ++r) { const int rc = (r & 3) + 8 * (r >> 2); if (!(rc > dq)) S[0][r] = -INFINITY; if (!(rc <= dq)) S[4][r] = -INFINITY; }
            float l = 0.f;
#pragma unroll
            for (int rel = 0; rel < 5; ++rel) { float ls = 0.f;
#pragma unroll
                for (int r = 0; r < 16; ++r) { const float p = fast_exp2(S[rel][r]); S[rel][r] = p; ls += p; }
                l += ls * drel[rel]; }
            l += __shfl_xor(l, 32);
            l += fast_exp2(sink2);
            const float inv0 = 1.0f / l;
            f32x16 o[2];
#pragma unroll
            for (int r = 0; r < 16; ++r) { o[0][r] = 0.f; o[1][r] = 0.f; }
#pragma unroll
            for (int rel = 0; rel < 5; ++rel) {
                const int blk = qs + rel;
                const bool valid = (qb > 0) || (blk >= 4);
                if (valid) {
                    const LAS unsigned char* vp = vbase + (blk >> 1) * 8192 + (blk & 1) * 2048;
                    const float inv = inv0 * drel[rel];
#pragma unroll
                    for (int s = 0; s < 2; ++s) {
                        u32x4 pw;
                        pw.x = cvt_pk_bf16(S[rel][8 * s + 0] * inv, S[rel][8 * s + 1] * inv); pw.y = cvt_pk_bf16(S[rel][8 * s + 2] * inv, S[rel][8 * s + 3] * inv);
                        pw.z = cvt_pk_bf16(S[rel][8 * s + 4] * inv, S[rel][8 * s + 5] * inv); pw.w = cvt_pk_bf16(S[rel][8 * s + 6] * inv, S[rel][8 * s + 7] * inv);
                        const bf16x8 pa = __builtin_bit_cast(bf16x8, pw);
#pragma unroll
                        for (int d0 = 0; d0 < 2; ++d0) {
                            const s16x4 lo = vtr(vp + d0 * 4096 + s * 1024), hh = vtr(vp + d0 * 4096 + s * 1024 + 512);
                            const bf16x8 vf = (bf16x8){lo[0], lo[1], lo[2], lo[3], hh[0], hh[1], hh[2], hh[3]};
                            o[d0] = __builtin_amdgcn_mfma_f32_32x32x16_bf16(pa, vf, o[d0], 0, 0, 0);
                        }
                    }
                }
            }
#pragma unroll
            for (int r = 0; r < 16; ++r) { const int orow = crow(r, hi);
#pragma unroll
                for (int d0 = 0; d0 < 2; ++d0) stg[orow * 64 + d0 * 32 + r32] = (bf16_t)(cvt_pk_bf16(o[d0][r], 0.f) & 0xffffu); }
            LDS_WAIT(); asm volatile("" ::: "memory");
            bf16_t* Ow = QO + (size_t)(T0 + 32 * qs) * D + h * 64;
#pragma unroll
            for (int i = 0; i < 4; ++i) { const int row = i * 8 + (lane >> 3), ch = lane & 7; const u32x4 v = *(const LAS u32x4*)(stg + row * 64 + ch * 8); *(u32x4*)(Ow + (size_t)row * D + ch * 8) = v; }
            LDS_WAIT(); asm volatile("" ::: "memory");
        }
        LDS_WAIT(); __builtin_amdgcn_s_barrier(); asm volatile("" ::: "memory");
    }
}

__device__ __forceinline__ unsigned okey(float v, int idx) { unsigned u = __float_as_uint(v); u = (u & 0x80000000u) ? ~u : (u | 0x80000000u); return (u & ~31u) | (unsigned)(31 - idx); }
__device__ __forceinline__ float okey_val(unsigned k) { unsigned u = k & ~31u; u = (u & 0x80000000u) ? (u & 0x7fffffffu) : ~u; return __uint_as_float(u); }
__device__ __forceinline__ void router_preload(const Args& args, LAS unsigned char* lds, int tid) {
    constexpr int WROW = 2064;
    const u32x4* src = (const u32x4*)(args.ws + WS_WRT);
    for (int idx = tid; idx < NE * D * 2 / 16; idx += 512) { const int e = idx >> 7, c = idx & 127; *(LAS u32x4*)(lds + e * WROW + c * 16) = src[idx]; }
    for (int idx = tid; idx < D / 4; idx += 512) ((LAS f32x4*)(lds + MISC_OFF + MISC_IDX))[idx] = ((const f32x4*)args.in[I_GFFN])[idx];
}
__device__ __forceinline__ void router_phase(const Args& args, LAS unsigned char* lds, int vcu, int G, int tid, int wave, int lane) {
    unsigned char* ws = args.ws;
    const bf16_t* X1B = (const bf16_t*)(ws + WS_R2); unsigned char* X1F8 = ws + WS_X1F8;
    float* tokw = (float*)(ws + WS_TOKW); int* list = (int*)(ws + WS_LIST);
    gu32* gcnt = (gu32*)(ws + WS_CTL) + CW_GCNT;
    constexpr int WROW = 2064;
    LAS int* hist = (LAS int*)(lds + MISC_OFF + MISC_HIST); LAS int* sbase = (LAS int*)(lds + MISC_OFF + MISC_SBASE);
    LAS int* etab = (LAS int*)(lds + MISC_OFF + MISC_ETAB); LAS int* ltab = (LAS int*)(lds + MISC_OFF + MISC_LTAB);
    if (N_LAUNCHES != 1) router_preload(args, lds, tid);
    const int ce = lane & 15, kg = lane >> 4;
    const float br0 = args.in[I_BR][ce], br1 = args.in[I_BR][16 + ce];
    for (int grp = vcu; grp < M / 128; grp += G) {
        if (tid < NE) hist[tid] = 0;
        LDS_WAIT(); __builtin_amdgcn_s_barrier(); asm volatile("" ::: "memory");
        const int tokb = grp * 128 + wave * 16, tokA = tokb + ce;
        f32x4 acc0 = (f32x4){0.f, 0.f, 0.f, 0.f}, acc1 = (f32x4){0.f, 0.f, 0.f, 0.f}; float ss = 0.f;
        const LAS unsigned char* wp = lds + ce * WROW + kg * 16;
        const bf16_t* xrow = X1B + (size_t)tokA * D + 8 * kg;
#pragma unroll 1
        for (int c = 0; c < 4; ++c) {
            u32x4 a[8];
#pragma unroll
            for (int i = 0; i < 8; ++i) a[i] = *(const u32x4*)(xrow + 32 * (8 * c + i));
#pragma unroll
            for (int i = 0; i < 8; ++i) {
                const int ks = 8 * c + i;
                const bf16x8 b0 = *(const LAS bf16x8*)(wp + ks * 64), b1 = *(const LAS bf16x8*)(wp + 16 * WROW + ks * 64);
                const bf16x8 av = __builtin_bit_cast(bf16x8, a[i]);
                acc0 = __builtin_amdgcn_mfma_f32_16x16x32_bf16(av, b0, acc0, 0, 0, 0);
                acc1 = __builtin_amdgcn_mfma_f32_16x16x32_bf16(av, b1, acc1, 0, 0, 0);
#pragma unroll
                for (int q = 0; q < 4; ++q) { const float lo = bf_lo(a[i][q]), hi = bf_hi(a[i][q]); ss += lo * lo + hi * hi; }
            }
        }
        ss += __shfl_xor(ss, 16); ss += __shfl_xor(ss, 32);
        const float rs = 1.0f / sqrtf(ss * (1.f / D) + EPS);
#pragma unroll 1
        for (int c = 0; c < 4; ++c) {
            u32x4 a[8];
#pragma unroll
            for (int i = 0; i < 8; ++i) a[i] = __builtin_nontemporal_load((const u32x4*)(xrow + 32 * (8 * c + i)));
#pragma unroll
            for (int i = 0; i < 8; ++i) {
                u32x2 pk;
                const LAS f32x4* gl = (const LAS f32x4*)(lds + MISC_OFF + MISC_IDX) + (32 * (8 * c + i) + 8 * kg) / 4;
                const f32x4 g0 = gl[0] * rs, g1 = gl[1] * rs;
                pk.x = pack4_fp8(bf_lo(a[i][0]) * g0[0], bf_hi(a[i][0]) * g0[1], bf_lo(a[i][1]) * g0[2], bf_hi(a[i][1]) * g0[3]);
                pk.y = pack4_fp8(bf_lo(a[i][2]) * g1[0], bf_hi(a[i][2]) * g1[1], bf_lo(a[i][3]) * g1[2], bf_hi(a[i][3]) * g1[3]);
                *(u32x2*)(X1F8 + (size_t)tokA * D + 32 * (8 * c + i) + 8 * kg) = pk;
            }
        }
#pragma unroll
        for (int r = 0; r < 4; ++r) {
            const float rsr = __shfl(rs, 4 * kg + r);
            unsigned k0 = okey(acc0[r] * rsr + br0, ce), k1 = okey(acc1[r] * rsr + br1, 16 + ce);
            float tv[4]; int te[4];
#pragma unroll
            for (int k = 0; k < 4; ++k) {
                unsigned m = k0 > k1 ? k0 : k1;
#pragma unroll
                for (int o = 1; o < 16; o <<= 1) { const unsigned t = (unsigned)__shfl_xor((int)m, o); m = t > m ? t : m; }
                const int sel = 31 - (int)(m & 31u); te[k] = sel; tv[k] = okey_val(m);
                if (sel == ce) k0 = 0u; if (sel == 16 + ce) k1 = 0u;
            }
            const float e1 = __expf(tv[1] - tv[0]), e2 = __expf(tv[2] - tv[0]), e3 = __expf(tv[3] - tv[0]);
            const float inv = 1.0f / (1.0f + e1 + e2 + e3);
            if (ce < 4) {
                const int ek = ce == 0 ? te[0] : ce == 1 ? te[1] : ce == 2 ? te[2] : te[3];
                const float wk = (ce == 0 ? 1.0f : ce == 1 ? e1 : ce == 2 ? e2 : e3) * inv;
                const int tli = wave * 16 + 4 * kg + r;
                const int lp = __hip_atomic_fetch_add(hist + ek, 1, __ATOMIC_RELAXED, __HIP_MEMORY_SCOPE_WORKGROUP);
                etab[tli * 4 + ce] = ek; ltab[tli * 4 + ce] = lp;
                tokw[(size_t)(tokb + 4 * kg + r) * 4 + ce] = wk;
            }
        }
        LDS_WAIT(); __builtin_amdgcn_s_barrier(); asm volatile("" ::: "memory");
        if (tid < NE) sbase[tid] = (int)__hip_atomic_fetch_add(gcnt + tid, (unsigned)hist[tid], RLX_AGENT);
        LDS_WAIT(); __builtin_amdgcn_s_barrier(); asm volatile("" ::: "memory");
        { const int e = etab[tid], pos = sbase[e] + ltab[tid]; list[(size_t)e * LIST_CAP + pos] = ((grp * 128 + (tid >> 2)) << 2) | (tid & 3);
          ((int*)(ws + WS_ROWOF))[grp * 512 + tid] = (e << 16) | pos; }
        LDS_WAIT(); __builtin_amdgcn_s_barrier(); asm volatile("" ::: "memory");
    }
}

__device__ __forceinline__ void build_moe_table(const Args& args, LAS unsigned char* lds, int tid) {
    LAS int* tbl = (LAS int*)(lds + MISC_OFF + MISC_TBL);
    gu32* gcnt = (gu32*)(args.ws + WS_CTL) + CW_GCNT;
    if (tid < 64) {
        const int c = (tid < NE) ? (int)__hip_atomic_load(gcnt + (tid & 31), RLX_AGENT) : 0; const int nrt = (c + 255) >> 8; int inc = nrt;
#pragma unroll
        for (int o = 1; o < 32; o <<= 1) { const int t = __shfl_up(inc, o); if ((tid & 63) >= o) inc += t; }
        if (tid < NE) tbl[tid] = inc - nrt; if (tid == NE - 1) tbl[NE] = inc;
        int ci = c;
#pragma unroll
        for (int o = 1; o < 32; o <<= 1) { const int t = __shfl_up(ci, o); if ((tid & 63) >= o) ci += t; }
        if (tid < NE) ((LAS int*)(lds + MISC_OFF + MISC_CPRE))[tid] = ci - c; if (tid == NE - 1) ((LAS int*)(lds + MISC_OFF + MISC_CPRE))[NE] = ci;
    }
    LDS_WAIT(); __syncthreads();
}

template <class Pre> __device__ __forceinline__ void final_phase(const Args& args, LAS unsigned char* lds, int vcu, int G, int wave, int lane, Pre pre) {
    unsigned char* ws = args.ws;
    const bf16_t* X1B = (const bf16_t*)(ws + WS_R2); const float* tokw = (const float*)(ws + WS_TOKW); const float* gfin = args.in[I_GFIN];
    const unsigned char* Y = ws + WS_Y; const int* rowof = (const int*)(ws + WS_ROWOF);
    const int gw = vcu * 8 + wave, NGW = G * 8;
    f32x4 gv[4];
#pragma unroll
    for (int q = 0; q < 4; ++q) gv[q] = *(const f32x4*)(gfin + 16 * lane + 4 * q);
    int cp;
    { const int c = (lane < NE) ? (int)__hip_atomic_load((gu32*)(ws + WS_CTL) + CW_GCNT + (lane & 31), RLX_AGENT) : 0; int inc = c;
#pragma unroll
      for (int o = 1; o < 32; o <<= 1) { const int t = __shfl_up(inc, o); if (lane >= o) inc += t; }
      cp = inc - c; }
    int4 rw[2];
#pragma unroll
    for (int t = 0; t < 2; ++t) { const int tok = gw + t * NGW; rw[t] = (tok < M) ? *(const int4*)(rowof + (size_t)tok * 4) : make_int4(0, 0, 0, 0); }
    pre();
    for (int tok0 = gw; tok0 < M; tok0 += 2 * NGW) {
        f32x4 w[2]; u32x4 xa[2], xb[2], y[2][4];
#pragma unroll
        for (int t = 0; t < 2; ++t) { const int tok = tok0 + t * NGW; if (tok < M) {
            const int iw[4] = {__builtin_amdgcn_readfirstlane(rw[t].x), __builtin_amdgcn_readfirstlane(rw[t].y), __builtin_amdgcn_readfirstlane(rw[t].z), __builtin_amdgcn_readfirstlane(rw[t].w)};
            int rk[4];
#pragma unroll
            for (int k = 0; k < 4; ++k) rk[k] = __builtin_amdgcn_readlane(cp, iw[k] >> 16) + (iw[k] & 0xffff);
            w[t] = *(const f32x4*)(tokw + (size_t)tok * 4);
            xa[t] = __builtin_nontemporal_load((const u32x4*)(X1B + (size_t)tok * D + 16 * lane)); xb[t] = __builtin_nontemporal_load((const u32x4*)(X1B + (size_t)tok * D + 16 * lane + 8));
#pragma unroll
            for (int k = 0; k < 4; ++k) y[t][k] = __builtin_nontemporal_load((const u32x4*)(Y + (size_t)rk[k] * 1024 + 16 * lane)); } }
#pragma unroll
        for (int t = 0; t < 2; ++t) { const int tok = tok0 + 2 * NGW + t * NGW; rw[t] = (tok < M) ? *(const int4*)(rowof + (size_t)tok * 4) : make_int4(0, 0, 0, 0); }
#pragma unroll
        for (int t = 0; t < 2; ++t) { const int tok = tok0 + t * NGW; if (tok < M) {
            f32x4 v[4];
            v[0] = (f32x4){bf_lo(xa[t].x), bf_hi(xa[t].x), bf_lo(xa[t].y), bf_hi(xa[t].y)}; v[1] = (f32x4){bf_lo(xa[t].z), bf_hi(xa[t].z), bf_lo(xa[t].w), bf_hi(xa[t].w)};
            v[2] = (f32x4){bf_lo(xb[t].x), bf_hi(xb[t].x), bf_lo(xb[t].y), bf_hi(xb[t].y)}; v[3] = (f32x4){bf_lo(xb[t].z), bf_hi(xb[t].z), bf_lo(xb[t].w), bf_hi(xb[t].w)};
            float s = 0.f;
#pragma unroll
            for (int q = 0; q < 4; ++q) {
#pragma unroll
                for (int k = 0; k < 4; ++k) {
                    const int word = (int)y[t][k][q];
                    const f32x2 lo = __builtin_amdgcn_cvt_pk_f32_fp8(word, false), hi = __builtin_amdgcn_cvt_pk_f32_fp8(word, true);
                    v[q] += w[t][k] * (f32x4){lo[0], lo[1], hi[0], hi[1]};
                }
                s += (v[q][0] * v[q][0] + v[q][1] * v[q][1]) + (v[q][2] * v[q][2] + v[q][3] * v[q][3]);
            }
            const float rstd = 1.0f / sqrtf(wave_sum(s) * (1.f / D) + EPS);
            asm volatile("" ::: "memory");
#pragma unroll
            for (int q = 0; q < 4; ++q) v[q] = v[q] * rstd * gv[q];
            LAS unsigned char* sc = lds + wave * 8192 + t * 4096;
#pragma unroll
            for (int q = 0; q < 4; ++q) *(LAS f32x4*)(sc + 64 * lane + 16 * ((q + lane) & 3)) = v[q];
            asm volatile("s_waitcnt lgkmcnt(0)" ::: "memory");
#pragma unroll
            for (int q = 0; q < 4; ++q) { const int ls = (lane >> 2) + 16 * q, qs = lane & 3;
                const f32x4 o = *(const LAS f32x4*)(sc + 64 * ls + 16 * ((qs + ls) & 3));
                __builtin_nontemporal_store(o, (f32x4*)(args.out + (size_t)tok * D + 256 * q + 4 * lane)); }
            asm volatile("" ::: "memory"); } }
    }
}

__global__ void __launch_bounds__(512, 2) mk_fwd(Args args) {
    extern __shared__ __attribute__((aligned(16))) unsigned char lds_raw[];
    LAS unsigned char* lds = (LAS unsigned char*)lds_raw;
    const int tid = threadIdx.x, lane = tid & 63, wave = __builtin_amdgcn_readfirstlane(tid >> 6);
    const int G = gridDim.x; const int bx = blockIdx.x; const int vcu = (G % 8 == 0) ? (bx % 8) * (G / 8) + bx / 8 : bx;
    unsigned char* ws = args.ws;
    gu32* ctl = (gu32*)(ws + WS_CTL);
    if (tid < 4) ((LAS unsigned*)(lds + MISC_OFF + MISC_XB))[tid] = 0u;
    __syncthreads();
    XcdBarrier bar; bar.bar = (unsigned*)ctl + CW_BAR; bar.x = 0; bar.st = nullptr;
    if (N_LAUNCHES == 1) bar = xcd_barrier_post((unsigned*)ctl + CW_BAR, (volatile LAS unsigned*)(lds + MISC_OFF + MISC_XB));
    const int lo = args.ph_lo, hi = args.ph_hi;
#ifndef ONLY_PHASE
#define ONLY_PHASE -1
#endif
#define IN(k) ((ONLY_PHASE < 0 || (k) == ONLY_PHASE) && lo <= (k) && (k) < hi)
#define BOTH(k) (IN(k) && IN((k) + 1))
#ifndef REP_BAR
#define REP_BAR 1
#endif
#define GRID_BAR() do { xcd_barrier(bar); if (REP_BAR >= 2) { xcd_barrier(bar); xcd_barrier(bar); } } while (0)

    if (IN(0)) { for (int rep = 0; rep < REP_P0; ++rep) { p0_prologue(args, lds, vcu, G, wave, lane); __syncthreads(); } if (BOTH(0)) GRID_BAR(); }

    if (IN(1)) {
        mg::DenseSched<1024> S; S.so.init(M, NIN, G, bx); S.A = (const char*)(ws + WS_R2); S.Bt = (const char*)(ws + WS_WIN);
        mg::EpiIn E{(const float*)(ws + WS_BPERM), (bf16_t*)(ws + WS_U), (bf16_t*)(ws + WS_QO), (bf16_t*)(ws + WS_KV), (bf16_t*)(ws + WS_RR), (bf16_t*)(ws + WS_GA), 0};
        if (bx >= G / 2) { p5_expert_weights(args, lds, 0, (bx - G / 2) * 8 + wave, (G / 2) * 8, CV_POOL0, wave, lane); }
        __syncthreads();
        mg::gemm_phase<mg::EpiIn, mg::DenseSched<1024>>(lds, S, E);
        if (REP_P1 >= 2 && REP_NULL == 2) { mg::EpiInT<false> E2{E.bperm, E.U, E.Q, E.KV, E.RR, E.GA, args.li}; mg::gemm_phase<mg::EpiInT<false>, mg::DenseSched<1024>>(lds, S, E2); }
        else if (REP_P1 >= 2) { if (REP_NULL == 1) { mg::EpiNull<mg::EpiIn> EN{E}; mg::gemm_phase<mg::EpiNull<mg::EpiIn>, mg::DenseSched<1024>>(lds, S, EN); } else mg::gemm_phase<mg::EpiIn, mg::DenseSched<1024>>(lds, S, E); }
        if (BOTH(1) && N_LAUNCHES != 1) GRID_BAR();
    }

    if (IN(2)) {
        const int g3 = (bx >> 3) % 3;
        auto bar12 = [&]() { if (N_LAUNCHES == 1) GRID_BAR(); };
        if (g3 == 2) { bar12(); attn_phase(args, lds, vcu, G, wave, lane); __syncthreads(); p5_expert_weights(args, lds, 2, vcu * 8 + wave, G * 8, CV_POOL2, wave, lane); __syncthreads(); }
        if (g3 == 0) { p5_expert_weights(args, lds, 2, vcu * 8 + wave, G * 8, CV_POOL2, wave, lane, bar12); __syncthreads(); }
        if (g3 == 1) conv_phase(args, lds, vcu, G, tid, wave, lane, bar12);
        else conv_phase(args, lds, vcu, G, tid, wave, lane);
        if (REP_CONV >= 2) { int t_ = threadIdx.x; asm volatile("" : "+v"(t_)); __syncthreads(); conv_phase(args, lds, vcu, G, t_, __builtin_amdgcn_readfirstlane(t_ >> 6), t_ & 63); }
        if (g3 != 2) attn_phase(args, lds, vcu, G, wave, lane);
        if (g3 == 1) { __syncthreads(); p5_expert_weights(args, lds, 2, vcu * 8 + wave, G * 8, CV_POOL2, wave, lane); }
        if (BOTH(2)) GRID_BAR();
    }

    if (IN(3)) {
        mg::MixSched S; S.so.init(M, D, G, bx); S.A0 = (const char*)(ws + WS_R2); S.A1 = (const char*)(ws + WS_QO); S.B0 = (const char*)(ws + WS_WCO); S.B1 = (const char*)(ws + WS_WAO);
        mg::EpiMix E{(const bf16_t*)(ws + WS_RR), (const bf16_t*)(ws + WS_GA), args.in[I_BCO], args.in[I_BAO], (bf16_t*)(ws + WS_MIX)};
        if (CVF_PAIRS > 0 && (vcu & 1)) { int t_ = threadIdx.x; asm volatile("" : "+v"(t_)); p5_expert_weights(args, lds, 3, vcu * 8 + __builtin_amdgcn_readfirstlane(t_ >> 6), G * 8, CV_FILL, __builtin_amdgcn_readfirstlane(t_ >> 6), t_ & 63); __syncthreads(); }
        mg::gemm_phase<mg::EpiMix, mg::MixSched>(lds, S, E);
        if (CVF_PAIRS > 0 && !(vcu & 1)) { int t_ = threadIdx.x; asm volatile("" : "+v"(t_)); p5_expert_weights(args, lds, 3, vcu * 8 + __builtin_amdgcn_readfirstlane(t_ >> 6), G * 8, CV_FILL, __builtin_amdgcn_readfirstlane(t_ >> 6), t_ & 63); }
        if (REP_P3 >= 2) { if (REP_NULL == 1) { mg::EpiNull<mg::EpiMix> EN{E}; mg::gemm_phase<mg::EpiNull<mg::EpiMix>, mg::MixSched>(lds, S, EN); } else mg::gemm_phase<mg::EpiMix, mg::MixSched>(lds, S, E); }
        if (BOTH(3)) GRID_BAR();
    }

    if (IN(4)) {
        mg::DenseSched<2048> S; S.so.init(M, D, G, bx); S.A = (const char*)(ws + WS_MIX); S.Bt = (const char*)(ws + WS_WO);
        mg::EpiRes E{args.in[I_X], (bf16_t*)(ws + WS_R2)};
        if (CVF_PAIRS > 0 && (vcu & 1)) { int t_ = threadIdx.x; asm volatile("" : "+v"(t_)); p5_expert_weights(args, lds, 4, vcu * 8 + __builtin_amdgcn_readfirstlane(t_ >> 6), G * 8, CV_FILL, __builtin_amdgcn_readfirstlane(t_ >> 6), t_ & 63); __syncthreads(); }
        mg::gemm_phase<mg::EpiRes, mg::DenseSched<2048>>(lds, S, E);
        if (CVF_PAIRS > 0 && !(vcu & 1)) { int t_ = threadIdx.x; asm volatile("" : "+v"(t_)); p5_expert_weights(args, lds, 4, vcu * 8 + __builtin_amdgcn_readfirstlane(t_ >> 6), G * 8, CV_FILL, __builtin_amdgcn_readfirstlane(t_ >> 6), t_ & 63); }
        if (REP_P4 >= 2) { if (REP_NULL == 1) { mg::EpiNull<mg::EpiRes> EN{E}; mg::gemm_phase<mg::EpiNull<mg::EpiRes>, mg::DenseSched<2048>>(lds, S, EN); } else mg::gemm_phase<mg::EpiRes, mg::DenseSched<2048>>(lds, S, E); }
        if (N_LAUNCHES == 1) { int t_ = threadIdx.x; asm volatile("" : "+v"(t_)); __syncthreads(); router_preload(args, lds, t_); }
        if (BOTH(4)) GRID_BAR();
    }

    if (IN(5)) {
        router_phase(args, lds, vcu, G, tid, wave, lane);
        if (BOTH(5)) GRID_BAR();
    }

    if (IN(6)) {
        build_moe_table(args, lds, tid);
        {
            const int rem = (((const LAS int*)(lds + MISC_OFF + MISC_TBL))[NE] * 8) % G, ns = G - rem;
            if (rem > 0 && ns >= G / 4) { if (vcu >= rem) p5_expert_weights(args, lds, 1, (vcu - rem) * 8 + wave, ns * 8, CV_POOL1, wave, lane); }
            else p5_expert_weights(args, lds, 1, vcu * 8 + wave, G * 8, CV_POOL1, wave, lane);
            __syncthreads();
        }
        mg::MoeSched<8, true, 1024> S{(const LAS int*)(lds + MISC_OFF + MISC_TBL), vcu, G, (const char*)(ws + WS_X1F8), (const char*)(ws + WS_WGU), (const int*)(ws + WS_LIST)};
        S.preload(lds, tid);
        mg::EpiSwiglu E{args.in[I_BG], args.in[I_BU], ws + WS_ACT};
        mg::gemm_phase<mg::EpiSwiglu, mg::MoeSched<8, true, 1024>>(lds, S, E);
        if (REP_P6 >= 2) { if (REP_NULL == 1) { mg::EpiNull<mg::EpiSwiglu> EN{E}; mg::gemm_phase<mg::EpiNull<mg::EpiSwiglu>, mg::MoeSched<8, true, 1024>>(lds, S, EN); } else mg::gemm_phase<mg::EpiSwiglu, mg::MoeSched<8, true, 1024>>(lds, S, E); }
        if (BOTH(6)) GRID_BAR();
    }

    if (IN(7)) {
        if (N_LAUNCHES != 1) build_moe_table(args, lds, tid);
        mg::MoeSched<4, false, 1024> S{(const LAS int*)(lds + MISC_OFF + MISC_TBL), vcu, G, (const char*)(ws + WS_ACT), (const char*)(ws + WS_WD), (const int*)(ws + WS_LIST)};
        S.preload(lds, tid);
        mg::EpiDown E{(const LAS int*)(lds + MISC_OFF), args.in[I_BD], ws + WS_Y};
        if (const int rem_ = (((const LAS int*)(lds + MISC_OFF + MISC_TBL))[NE] * 4) % G; STAG_P7 > 0 && rem_ > 0 && vcu >= rem_) { for (int i = 0; i < STAG_P7; ++i) __builtin_amdgcn_s_sleep(127); }
        mg::gemm_phase<mg::EpiDown, mg::MoeSched<4, false, 1024>>(lds, S, E);
        if (REP_P7 >= 2) { if (REP_NULL == 1) { mg::EpiNull<mg::EpiDown> EN{E}; mg::gemm_phase<mg::EpiNull<mg::EpiDown>, mg::MoeSched<4, false, 1024>>(lds, S, EN); } else mg::gemm_phase<mg::EpiDown, mg::MoeSched<4, false, 1024>>(lds, S, E); }
        if (BOTH(7) && N_LAUNCHES != 1) GRID_BAR();
    }

    if (IN(8)) { int t_ = threadIdx.x; asm volatile("" : "+v"(t_)); const int lane8 = t_ & 63, wave8 = __builtin_amdgcn_readfirstlane(t_ >> 6);
        final_phase(args, lds, vcu, G, wave8, lane8, [&]() { if (N_LAUNCHES == 1) GRID_BAR(); });
        if (REP_P8 >= 2) { __syncthreads(); final_phase(args, lds, vcu, G, wave8, lane8, []() {}); } }
#undef IN
#undef BOTH
#undef GRID_BAR
}

extern "C" void kernel_launch(void* const* d_in, const int* in_sizes, int n_in, void* d_out, int out_size, void* d_ws, size_t ws_size, hipStream_t stream) {
    static int grid = 0;
    if (grid == 0) {
        if (n_in != 24 || in_sizes[0] != M * D || out_size != M * D || ws_size < WS_END) { fprintf(stderr, "kernel_launch: unexpected shapes / workspace (%zu < %zu); nothing launched\n", ws_size, (size_t)WS_END); grid = -1; return; }
        int dev = 0, cus = 0, per_cu = 0;
        if (hipGetDevice(&dev) != hipSuccess || hipDeviceGetAttribute(&cus, hipDeviceAttributeMultiprocessorCount, dev) != hipSuccess) { grid = -1; return; }
        if (hipFuncSetAttribute((const void*)mk_fwd, hipFuncAttributeMaxDynamicSharedMemorySize, LDS_BYTES) != hipSuccess) { fprintf(stderr, "kernel_launch: hipFuncSetAttribute failed\n"); grid = -1; return; }
        if (hipOccupancyMaxActiveBlocksPerMultiprocessor(&per_cu, (const void*)mk_fwd, 512, LDS_BYTES) != hipSuccess || per_cu < 1) { fprintf(stderr, "kernel_launch: occupancy query says %d\n", per_cu); }
        (void)hipGetLastError();
        grid = cus;
    }
    if (grid < 0) return;
    if (hipMemsetAsync((char*)d_ws + WS_CTL, 0, CTL_ZERO_BYTES, stream) != hipSuccess) return;
    Args a{};
    for (int i = 0; i < 24; ++i) a.in[i] = (const float*)d_in[i];
    a.out = (float*)d_out; a.ws = (unsigned char*)d_ws;
    if (N_LAUNCHES == 1) {
        a.ph_lo = 0; a.ph_hi = N_PHASES; a.li = 0;
        hipLaunchKernelGGL(mk_fwd, dim3(grid), dim3(512), LDS_BYTES, stream, a);
    } else {
        for (int li = 0; li < N_PHASES; ++li) { a.ph_lo = li; a.ph_hi = li + 1; a.li = li; hipLaunchKernelGGL(mk_fwd, dim3(grid), dim3(512), LDS_BYTES, stream, a); }
    }
}
```
